# Optimizing an MI355X kernel written in HIP

```python
import math
import jax, jax.numpy as jnp
from jax import lax
import numpy as np

D_MODEL = 1024
BATCH = 32
SEQ = 2048
DEPTH = 1

HEAD_DIM = 64
DIFF_HEADS = 4
DIFF_QK = 2 * HEAD_DIM
DIFF_V = 2 * HEAD_DIM
DIFF_WIDTH = DIFF_HEADS * DIFF_V
SWA_Q_HEADS = 8
SWA_KV_HEADS = 2
SWA_GROUP = SWA_Q_HEADS // SWA_KV_HEADS
SWA_WIDTH = SWA_Q_HEADS * HEAD_DIM
WINDOW = 128
BLOCK = 128
MIX_WIDTH = DIFF_WIDTH + SWA_WIDTH
N_ATT_HEADS = SWA_Q_HEADS + DIFF_HEADS
COL_DQ = DIFF_HEADS * DIFF_QK
COL_DK = DIFF_HEADS * DIFF_QK
COL_DV = DIFF_HEADS * DIFF_V
COL_SQ = SWA_Q_HEADS * HEAD_DIM
COL_SK = SWA_KV_HEADS * HEAD_DIM
COL_SV = SWA_KV_HEADS * HEAD_DIM
IN_WIDTH = COL_DQ + COL_DK + COL_DV + COL_SQ + COL_SK + COL_SV
SPLITS = (COL_DQ, COL_DQ + COL_DK, COL_DQ + COL_DK + COL_DV, COL_DQ + COL_DK + COL_DV + COL_SQ, COL_DQ + COL_DK + COL_DV + COL_SQ + COL_SK)
PEER_HEADS = 8
N_KEYS = 128
N_EXPERTS = N_KEYS * N_KEYS
PEER_QUERY = 256
PEER_HALF = PEER_QUERY // 2
PEER_TOPK = 16
PEER_CHUNK = 128
LN_EPS = 1e-5
DEEPNORM_ALPHA = (2 * DEPTH) ** 0.25
DEEPNORM_BETA = (8 * DEPTH) ** -0.25
NEG_INF = -1e30

kernel_name = "hybrid_diffattn_swa_peer_deepnorm"


def layer_norm(x, g, b):
    xf = x.astype(jnp.float32)
    mu = jnp.mean(xf, axis=-1, keepdims=True)
    var = jnp.mean(jnp.square(xf - mu), axis=-1, keepdims=True)
    return ((xf - mu) * lax.rsqrt(var + LN_EPS)).astype(x.dtype) * g + b


def rms_norm(x, g):
    xf = x.astype(jnp.float32)
    return (xf * lax.rsqrt(jnp.mean(xf * xf, axis=-1, keepdims=True) + LN_EPS)).astype(x.dtype) * g


def alibi_slopes():
    i = jnp.arange(1, N_ATT_HEADS + 1, dtype=jnp.float32)
    return jnp.exp2(-8.0 * i / N_ATT_HEADS)


def diff_attention(q, k, v, lq1, lk1, lq2, lk2, subln_g, slopes, lambda_init):
    B_, S_ = q.shape[0], q.shape[1]
    lam = (jnp.exp(jnp.sum((lq1 * lk1).astype(jnp.float32)))
           - jnp.exp(jnp.sum((lq2 * lk2).astype(jnp.float32))) + lambda_init)
    scale = HEAD_DIM ** -0.5
    outs = []
    for blk in range(S_ // BLOCK):
        start, end = blk * BLOCK, (blk + 1) * BLOCK
        qb = q[:, start:end]
        kp = k[:, :end]
        vp = v[:, :end]
        s = jnp.einsum('bqhmd,bkhmd->bhmqk', qb, kp).astype(jnp.float32) * scale
        dist = (jnp.arange(start, end)[:, None] - jnp.arange(end)[None, :]).astype(jnp.float32)
        bias = -slopes[:, None, None, None] * dist[None, None]
        s = jnp.where(dist >= 0, s + bias, NEG_INF)
        p = jax.nn.softmax(s, axis=-1)
        a = p[:, :, 0] - lam * p[:, :, 1]
        outs.append(jnp.einsum('bhqk,bkhe->bqhe', a.astype(v.dtype), vp))
    o = jnp.concatenate(outs, axis=1)
    o = rms_norm(o, subln_g) * (1.0 - lambda_init)
    return o.reshape(B_, S_, DIFF_WIDTH)


def swa_attention(q, k, v, sinks, slopes):
    B_, S_ = q.shape[0], q.shape[1]
    nb = S_ // BLOCK
    qb = q.reshape(B_, nb, BLOCK, SWA_KV_HEADS, SWA_GROUP, HEAD_DIM)

    def banded(z):
        zb = z.reshape(B_, nb, BLOCK, SWA_KV_HEADS, HEAD_DIM)
        prev = jnp.pad(zb, ((0, 0), (1, 0), (0, 0), (0, 0), (0, 0)))[:, :-1]
        return jnp.concatenate([prev, zb], axis=2)

    kb, vb = banded(k), banded(v)
    s = jnp.einsum('bnqhgd,bnkhd->bnhgqk', qb, kb).astype(jnp.float32) * (HEAD_DIM ** -0.5)
    i = jnp.arange(BLOCK)[:, None]
    j = jnp.arange(2 * BLOCK)[None, :]
    dist = i - j + BLOCK
    key_pos = jnp.arange(nb)[:, None, None] * BLOCK - BLOCK + j[None]
    valid = (dist >= 0) & (dist < WINDOW) & (key_pos >= 0)
    sl = slopes.reshape(SWA_KV_HEADS, SWA_GROUP)[:, :, None, None]
    s = s - sl * dist.astype(jnp.float32)
    s = jnp.where(valid[:, None, None], s, NEG_INF)
    sink = sinks.astype(jnp.float32).reshape(SWA_KV_HEADS, SWA_GROUP)[:, :, None, None]
    m = jnp.maximum(jnp.max(s, axis=-1, keepdims=True), sink)
    p = jnp.exp(s - m)
    p = p / (jnp.sum(p, axis=-1, keepdims=True) + jnp.exp(sink - m))
    o = jnp.einsum('bnhgqk,bnkhd->bnqhgd', p.astype(v.dtype), vb)
    return o.reshape(B_, S_, SWA_WIDTH)


def peer(h, w_pq, sub_keys, u_tab, v_tab):
    B_, S_, D = h.shape
    hc = h.reshape(-1, PEER_CHUNK, D)

    def chunk(hx):
        q = (hx @ w_pq).reshape(PEER_CHUNK, PEER_HEADS, 2, PEER_HALF)
        sc = jnp.einsum('thpd,hpnd->thpn', q, sub_keys).astype(jnp.float32)
        v_half, i_half = lax.top_k(sc, PEER_TOPK)
        cand = v_half[:, :, 0, :, None] + v_half[:, :, 1, None, :]
        cand_idx = i_half[:, :, 0, :, None] * N_KEYS + i_half[:, :, 1, None, :]
        cand = cand.reshape(PEER_CHUNK, PEER_HEADS, PEER_TOPK * PEER_TOPK)
        cand_idx = cand_idx.reshape(PEER_CHUNK, PEER_HEADS, PEER_TOPK * PEER_TOPK)
        top_s, top_pos = lax.top_k(cand, PEER_TOPK)
        idx = jnp.take_along_axis(cand_idx, top_pos, axis=-1)
        g = jax.nn.softmax(top_s, axis=-1)
        a = jax.nn.gelu(jnp.einsum('thkd,td->thk', u_tab[idx], hx), approximate=False)
        return jnp.einsum('thk,thkd->td', (g * a).astype(hx.dtype), v_tab[idx])

    return lax.map(chunk, hc).reshape(B_, S_, D)


def setup_inputs(seed: int = 0) -> dict:
    key = jax.random.key(seed)
    ks = jax.random.split(key, 20)
    f32 = jnp.float32

    def nrm(k, shape, s):
        return jax.random.normal(k, shape, f32) * s

    col = jnp.arange(IN_WIDTH)
    is_v = ((col >= SPLITS[1]) & (col < SPLITS[2])) | (col >= SPLITS[4])
    col_scale = jnp.where(is_v, DEEPNORM_BETA, 1.0).astype(f32)
    L, D = DEPTH, D_MODEL
    return {
        "x": nrm(ks[0], (BATCH, SEQ, D), 1.0),
        "c": nrm(ks[1], (BATCH, D), 1.0),
        "w_ada": nrm(ks[2], (L, D, 6 * D), D ** -0.5),
        "b_ada": nrm(ks[3], (L, 6 * D), 0.01),
        "w_in": nrm(ks[4], (L, D, IN_WIDTH), D ** -0.5) * col_scale,
        "lambda_q1": nrm(ks[5], (L, HEAD_DIM), 0.1),
        "lambda_k1": nrm(ks[6], (L, HEAD_DIM), 0.1),
        "lambda_q2": nrm(ks[7], (L, HEAD_DIM), 0.1),
        "lambda_k2": nrm(ks[8], (L, HEAD_DIM), 0.1),
        "subln_g": 1.0 + nrm(ks[9], (L, DIFF_V), 0.02),
        "sinks": nrm(ks[10], (L, SWA_Q_HEADS), 0.5),
        "w_out": nrm(ks[11], (L, MIX_WIDTH, D), MIX_WIDTH ** -0.5 * DEEPNORM_BETA),
        "ln1_g": 1.0 + nrm(ks[12], (L, D), 0.02),
        "ln1_b": nrm(ks[13], (L, D), 0.02),
        "w_pq": nrm(ks[14], (L, D, PEER_HEADS * PEER_QUERY), D ** -0.5),
        "sub_keys": nrm(ks[15], (L, PEER_HEADS, 2, N_KEYS, PEER_HALF), PEER_HALF ** -0.5),
        "u_tab": nrm(ks[16], (L, N_EXPERTS, D), D ** -0.5 * DEEPNORM_BETA),
        "v_tab": nrm(ks[17], (L, N_EXPERTS, D), DEEPNORM_BETA),
        "ln2_g": 1.0 + nrm(ks[18], (L, D), 0.02),
        "ln2_b": nrm(ks[19], (L, D), 0.02),
    }


def reference(x, c, w_ada, b_ada, w_in, lambda_q1, lambda_k1, lambda_q2, lambda_k2, subln_g, sinks, w_out, ln1_g, ln1_b, w_pq, sub_keys, u_tab, v_tab, ln2_g, ln2_b):
    B_, S_, _ = x.shape
    slopes = alibi_slopes()
    swa_slopes = slopes[:SWA_Q_HEADS]
    diff_slopes = slopes[SWA_Q_HEADS:]
    for l in range(DEPTH):
        lambda_init = 0.8 - 0.6 * math.exp(-0.3 * l)
        mod = jax.nn.silu(c) @ w_ada[l] + b_ada[l]
        sh1, sc1, g1, sh2, sc2, g2 = jnp.split(mod[:, None, :], 6, axis=-1)
        h = x * (1.0 + sc1) + sh1
        proj = h @ w_in[l]
        dq, dk, dv, sq, sk, sv = jnp.split(proj, SPLITS, axis=-1)
        diff_out = diff_attention(
            dq.reshape(B_, S_, DIFF_HEADS, 2, HEAD_DIM),
            dk.reshape(B_, S_, DIFF_HEADS, 2, HEAD_DIM),
            dv.reshape(B_, S_, DIFF_HEADS, DIFF_V),
            lambda_q1[l], lambda_k1[l], lambda_q2[l], lambda_k2[l], subln_g[l],
            diff_slopes, lambda_init)
        swa_out = swa_attention(
            sq.reshape(B_, S_, SWA_KV_HEADS, SWA_GROUP, HEAD_DIM),
            sk.reshape(B_, S_, SWA_KV_HEADS, HEAD_DIM),
            sv.reshape(B_, S_, SWA_KV_HEADS, HEAD_DIM),
            sinks[l], swa_slopes)
        mixed = jnp.concatenate([diff_out, swa_out], axis=-1) @ w_out[l]
        x = layer_norm(DEEPNORM_ALPHA * x + g1 * mixed, ln1_g[l], ln1_b[l])
        h = x * (1.0 + sc2) + sh2
        ffn = peer(h, w_pq[l], sub_keys[l], u_tab[l], v_tab[l])
        x = layer_norm(DEEPNORM_ALPHA * x + g2 * ffn, ln2_g[l], ln2_b[l])
    return x
```

```cpp
#include <hip/hip_runtime.h>
#include <hip/hip_cooperative_groups.h>
#include <stdint.h>
#include <cstdio>

namespace {
typedef unsigned short bf16_t;
typedef short bf16x8 __attribute__((ext_vector_type(8)));
typedef short s16x4 __attribute__((ext_vector_type(4)));
typedef float f32x4 __attribute__((ext_vector_type(4)));
typedef float f32x16 __attribute__((ext_vector_type(16)));
typedef unsigned u32x4 __attribute__((ext_vector_type(4)));
typedef unsigned u32x2 __attribute__((ext_vector_type(2)));
constexpr float LOG2E = 1.4426950408889634f;
constexpr float QSCALE = 0.125f * LOG2E;
typedef __bf16 bf16pair_t __attribute__((ext_vector_type(2)));
__device__ __forceinline__ unsigned cvtpk(float lo, float hi) { bf16pair_t v; v[0] = (__bf16)lo; v[1] = (__bf16)hi; return __builtin_bit_cast(unsigned, v); }
__device__ __forceinline__ int opaque_tid() { int t = threadIdx.x; asm volatile("" : "+v"(t)); return t; }
__device__ __forceinline__ int wave_of(int tid) { return __builtin_amdgcn_readfirstlane(tid >> 6); }
__device__ __forceinline__ float bf2f(bf16_t b) { return __uint_as_float((unsigned)b << 16); }
__device__ __forceinline__ float bflo(unsigned w) { return __uint_as_float(w << 16); }
__device__ __forceinline__ float bfhi(unsigned w) { return __uint_as_float(w & 0xffff0000u); }

constexpr int D = 1024, NB = 32, S = 2048, T = NB * S;
constexpr int INW = 2304, MODW = 6144;
constexpr float LN_EPS = 1e-5f;
constexpr float ALPHA = 1.189207115002721f;
constexpr float LAMBDA_INIT = 0.2f;
constexpr int SH1 = 0, SC1 = 1024, G1 = 2048, SH2 = 3072, SC2 = 4096, G2 = 5120;
__device__ __forceinline__ size_t tm_act(int r, int k) { return (size_t)(r >> 7) * 131072 + (size_t)((k >> 5) * 4096 + (r & 127) * 32 + (k & 31)); }
__device__ __forceinline__ size_t tm_w(int n, int k, int N) { return ((size_t)(k >> 5) * N + n) * 32 + (k & 31); }


struct Params {
    const float *x, *c, *w_ada, *b_ada, *w_in, *lq1, *lk1, *lq2, *lk2, *subln_g, *sinks, *w_out, *ln1_g, *ln1_b, *w_pq, *sub_keys, *u_tab, *v_tab, *ln2_g, *ln2_b;
    float* out;
    float* mod;
    bf16_t* w_in_t;
    bf16_t* w_out_t;
    bf16_t* weff_t;
    unsigned char* u_q;
    unsigned char* v_q;
    float* u_sc;
    unsigned char* u_m;
    unsigned char* v_m;
    float* v_sc;
    bf16_t* hbuf;
    bf16_t* proj;
    bf16_t* attn;
    bf16_t* y1;
    unsigned* hq;
    float* hsc;
    bf16_t* x1;
    int* hk;
    int* eidx;
    float* gw;
    unsigned* bar;
    float* scal;
};

extern __shared__ __attribute__((aligned(16))) char smem[];

constexpr int PREP_MOD = 384;
constexpr int PREP_TIN = 16 * 36;
constexpr int PREP_TOUT = 16 * 16;
constexpr int PREP_WEFF = 16 * 2 * 32;
constexpr int PREP_CVT = 512;
constexpr int PREP_REST = PREP_TIN + PREP_TOUT + PREP_WEFF + 2 * PREP_CVT;

__device__ __forceinline__ void tr_tile(const float* __restrict__ src, int N, int K, bf16_t* __restrict__ dst, int kt, int nt, float* lds) {
    const int tid = opaque_tid();
#pragma unroll
    for (int i = 0; i < 16; ++i) { const int idx = tid + i * 256, r = idx >> 6, cc = idx & 63; lds[r * 65 + cc] = src[(size_t)(kt * 64 + r) * N + nt * 64 + cc]; }
    __syncthreads();
#pragma unroll
    for (int i = 0; i < 16; ++i) { const int idx = tid + i * 256, n = idx >> 6, k = idx & 63; dst[tm_w(nt * 64 + n, kt * 64 + k, N)] = (bf16_t)(cvtpk(lds[k * 65 + n], 0.f) & 0xffffu); }
    __syncthreads();
}

__device__ __forceinline__ void mod_item(const Params& p, int item) {
    const int tid = opaque_tid(), lane = tid & 63, wid = wave_of(tid);
    float* lds = (float*)smem;
    const int cb = item >> 2, bg = item & 3, j = cb * 64 + lane;
    for (int i = tid; i < 8192; i += 256) { const int b = i >> 10, k = i & 1023; const float v = p.c[(bg * 8 + b) * D + k]; lds[k * 8 + b] = v / (1.0f + expf(-v)); }
    __syncthreads();
    float acc[8];
#pragma unroll
    for (int b = 0; b < 8; ++b) acc[b] = 0.f;
    const float* wp = p.w_ada + (size_t)(wid * 256) * MODW + j;
#pragma unroll 4
    for (int k = 0; k < 256; ++k) {
        const float wv = wp[(size_t)k * MODW];
        const f32x4 s0 = *(const f32x4*)(lds + (wid * 256 + k) * 8), s1 = *(const f32x4*)(lds + (wid * 256 + k) * 8 + 4);
        acc[0] += s0[0] * wv; acc[1] += s0[1] * wv; acc[2] += s0[2] * wv; acc[3] += s0[3] * wv;
        acc[4] += s1[0] * wv; acc[5] += s1[1] * wv; acc[6] += s1[2] * wv; acc[7] += s1[3] * wv;
    }
    float* red = lds + 8192;
#pragma unroll
    for (int b = 0; b < 8; ++b) red[(wid * 8 + b) * 64 + lane] = acc[b];
    __syncthreads();
#pragma unroll
    for (int r = 0; r < 2; ++r) {
        const int o = tid + 256 * r, b = o >> 6, col = o & 63;
        const float s = (red[(0 * 8 + b) * 64 + col] + red[(1 * 8 + b) * 64 + col]) + (red[(2 * 8 + b) * 64 + col] + red[(3 * 8 + b) * 64 + col]);
        p.mod[(bg * 8 + b) * MODW + cb * 64 + col] = s + p.b_ada[cb * 64 + col];
    }
    if (item == 0 && tid == 0) {
        float s1 = 0.f, s2 = 0.f;
        for (int i = 0; i < 64; ++i) { s1 += p.lq1[i] * p.lk1[i]; s2 += p.lq2[i] * p.lk2[i]; }
        p.scal[0] = expf(s1) - expf(s2) + LAMBDA_INIT;
    }
    __syncthreads();
}

__device__ __forceinline__ void prep_item(const Params& p, int item) {
    const int tid = opaque_tid();
    float* lds = (float*)smem;
    if (item < PREP_TIN) { tr_tile(p.w_in, INW, D, p.w_in_t, item / 36, item % 36, lds); return; }
    item -= PREP_TIN;
    if (item < PREP_TOUT) { tr_tile(p.w_out, D, D, p.w_out_t, item / 16, item % 16, lds); return; }
    item -= PREP_TOUT;
    if (item < PREP_WEFF) {
        const int hp = item >> 6, nh = (item >> 5) & 1, ct = item & 31;
        float* ks = lds;
        float* wsm = lds + 64 * 129;
        for (int i = tid; i < 64 * 128; i += 256) { const int n = i >> 7, d = i & 127; ks[n * 129 + d] = p.sub_keys[((size_t)hp * 128 + nh * 64 + n) * 128 + d]; }
        for (int i = tid; i < 32 * 128; i += 256) { const int cc = i >> 7, d = i & 127; wsm[cc * 128 + d] = p.w_pq[(size_t)(ct * 32 + cc) * 2048 + hp * 128 + d]; }
        __syncthreads();
        const int n = tid & 63, cb = (tid >> 6) * 8;
        float acc[8];
#pragma unroll
        for (int cc = 0; cc < 8; ++cc) acc[cc] = 0.f;
        for (int d = 0; d < 128; ++d) { const float kv = ks[n * 129 + d];
#pragma unroll
            for (int cc = 0; cc < 8; ++cc) acc[cc] += kv * wsm[(cb + cc) * 128 + d]; }
        u32x4 w; w.x = cvtpk(acc[0], acc[1]); w.y = cvtpk(acc[2], acc[3]); w.z = cvtpk(acc[4], acc[5]); w.w = cvtpk(acc[6], acc[7]);
        *(u32x4*)(p.weff_t + tm_w(hp * 128 + nh * 64 + n, ct * 32 + cb, 2048)) = w;
        __syncthreads();
        return;
    }
    item -= PREP_WEFF;
    {
        const bool isv = item >= PREP_CVT;
        const float* src = isv ? p.v_tab : p.u_tab; unsigned char* dst = isv ? p.v_q : p.u_q; unsigned char* mdst = isv ? p.v_m : p.u_m; float* scl = isv ? p.v_sc : p.u_sc;
        const int lane = tid & 63, wid = wave_of(tid);
        for (int i0 = 0; i0 < 8; i0 += 4) {
            f32x4 vv[4][4];
#pragma unroll
            for (int r = 0; r < 4; ++r) { const float* rp = src + (size_t)((item % PREP_CVT) * 32 + wid * 8 + i0 + r) * D + lane * 16;
#pragma unroll
                for (int j = 0; j < 4; ++j) vv[r][j] = *(const f32x4*)(rp + 4 * j); }
#pragma unroll
            for (int r = 0; r < 4; ++r) {
                const int e = (item % PREP_CVT) * 32 + wid * 8 + i0 + r;
                float gm = 0.f;
#pragma unroll
                for (int j = 0; j < 4; ++j) gm = fmaxf(gm, fmaxf(fmaxf(fabsf(vv[r][j][0]), fabsf(vv[r][j][1])), fmaxf(fabsf(vv[r][j][2]), fabsf(vv[r][j][3]))));
                float am = gm;
#pragma unroll
                for (int o = 32; o > 0; o >>= 1) am = fmaxf(am, __shfl_xor(am, o));
                am = fmaxf(am, 1e-30f);
                gm = fmaxf(gm, __shfl_xor(gm, 1));
                int mq = (int)ceilf(gm * 255.0f / am); mq = mq < 1 ? 1 : (mq > 255 ? 255 : mq); if (isv) mq = 255;
                const float gi = 7.0f * 255.0f / (am * (float)mq);
                unsigned w0 = 0u, w1 = 0u;
#pragma unroll
                for (int j = 0; j < 4; ++j)
#pragma unroll
                    for (int q = 0; q < 4; ++q) {
                        int n = (int)rintf(vv[r][j][q] * gi); n = n < -7 ? -7 : (n > 7 ? 7 : n); n = isv ? n + 8 : (n & 15);
                        const int idx = 4 * j + q;
                        if (idx < 8) w0 |= (unsigned)n << (4 * idx); else w1 |= (unsigned)n << (4 * (idx - 8));
                    }
                u32x2 ww; ww.x = w0; ww.y = w1;
                *(u32x2*)(dst + (size_t)e * 512 + lane * 8) = ww;
                if ((lane & 1) == 0) mdst[(size_t)e * 32 + (lane >> 1)] = (unsigned char)mq;
                if (lane == 0) scl[e] = am * (1.0f / (255.0f * 7.0f));
            }
        }
    }
}

__device__ __forceinline__ void modulate_rows(const float* __restrict__ x, const float* __restrict__ mod, int sh_off, int sc_off, bf16_t* __restrict__ h, int r0, int nrows) {
    const int tid = opaque_tid();
    for (int i = tid; i < nrows * 128; i += 256) {
        const int r = r0 + (i >> 7), k = (i & 127) * 8, b = r / S;
        const float* xp = x + (size_t)r * D + k; const float* sc = mod + b * MODW + sc_off + k; const float* sh = mod + b * MODW + sh_off + k;
        const float4 x0 = *(const float4*)xp, x1v = *(const float4*)(xp + 4), c0 = *(const float4*)sc, c1 = *(const float4*)(sc + 4), s0 = *(const float4*)sh, s1 = *(const float4*)(sh + 4);
        u32x4 w;
        w.x = cvtpk(x0.x * (1.f + c0.x) + s0.x, x0.y * (1.f + c0.y) + s0.y); w.y = cvtpk(x0.z * (1.f + c0.z) + s0.z, x0.w * (1.f + c0.w) + s0.w);
        w.z = cvtpk(x1v.x * (1.f + c1.x) + s1.x, x1v.y * (1.f + c1.y) + s1.y); w.w = cvtpk(x1v.z * (1.f + c1.z) + s1.z, x1v.w * (1.f + c1.w) + s1.w);
        *(u32x4*)(h + tm_act(r, k)) = w;
    }
}

constexpr int GEMM_STAGE = 24576;
constexpr int GEMM_LDS = 3 * GEMM_STAGE;
constexpr int GK = 1024;
#define GLDS16(gp, off) __builtin_amdgcn_global_load_lds((const unsigned*)(gp), (__attribute__((address_space(3))) unsigned*)(smem + (off)), 16, 0, 0)
template <class Epi>
__device__ __forceinline__ void gemm_tile(const bf16_t* __restrict__ A, const bf16_t* __restrict__ Bt, int BN, int m0, int n0, char* lds, Epi& epi) {
    const int tid = opaque_tid(), lane = tid & 63, wid = wave_of(tid), wm = wid >> 1, wn = wid & 1;
    const int swz = (((lane & 3) ^ ((0 - (lane >> 4)) & 3)) * 8), r16 = lane >> 2;
    const int goff = r16 * 32 + swz;
    const int goffB = Epi::PERM ? (8 * (r16 >> 2) + (r16 & 3)) * 32 + swz : goff;
    constexpr int BQ1 = Epi::PERM ? 4 * 32 : 16 * 32, BQ2 = 32 * 32, BQ3 = Epi::PERM ? 36 * 32 : 48 * 32;
    const bf16_t* Ab = A + (size_t)m0 * GK + wid * 1024 + goff; const bf16_t* Bb = Bt + (size_t)(n0 + wid * 64) * 32 + goffB;
    const int bks = BN * 32;
    const int dstA = wid * 2048, dstB = 8192 + wid * 4096;
    const int fsw = (((lane >> 4) ^ (0 - ((lane & 15) >> 2))) & 3) * 16;
    const int fa = (wm * 64 + (lane & 15)) * 64 + fsw, fb = 8192 + (wn * 128 + (lane & 15)) * 64 + fsw;
    f32x4 acc[4][8];
#pragma unroll
    for (int i = 0; i < 4; ++i)
#pragma unroll
        for (int j = 0; j < 8; ++j) acc[i][j] = (f32x4){0.f, 0.f, 0.f, 0.f};
    constexpr int nk = GK / 32;
#define GEMM_STAGE_LOAD(kt, st) do { const int so_ = (st) * GEMM_STAGE; \
        GLDS16(Ab + (kt) * 4096, so_ + dstA); GLDS16(Ab + (kt) * 4096 + 512, so_ + dstA + 1024); const bf16_t* bq_ = Bb + (size_t)(kt) * bks; \
        GLDS16(bq_, so_ + dstB); GLDS16(bq_ + BQ1, so_ + dstB + 1024); GLDS16(bq_ + BQ2, so_ + dstB + 2048); GLDS16(bq_ + BQ3, so_ + dstB + 3072); } while (0)
    GEMM_STAGE_LOAD(0, 0);
    GEMM_STAGE_LOAD(1, 1);
    int cur = 0, nx2 = 2 * GEMM_STAGE;
#pragma unroll 1
    for (int kt = 0; kt < nk; ++kt) {
        if (kt + 1 < nk) asm volatile("s_waitcnt vmcnt(6)" ::: "memory"); else asm volatile("s_waitcnt vmcnt(0)" ::: "memory");
        __builtin_amdgcn_s_barrier();
        asm volatile("" ::: "memory");
        bf16x8 af[4], bfr[8];
#pragma unroll
        for (int i = 0; i < 4; ++i) af[i] = *(const bf16x8*)(lds + cur + fa + i * 1024);
#pragma unroll
        for (int j = 0; j < 8; ++j) bfr[j] = *(const bf16x8*)(lds + cur + fb + j * 1024);
        __builtin_amdgcn_sched_barrier(0);
        if (kt + 2 < nk) { const int so_ = nx2;
            GLDS16(Ab + (kt + 2) * 4096, so_ + dstA); GLDS16(Ab + (kt + 2) * 4096 + 512, so_ + dstA + 1024); const bf16_t* bq_ = Bb + (size_t)(kt + 2) * bks;
            GLDS16(bq_, so_ + dstB); GLDS16(bq_ + BQ1, so_ + dstB + 1024); GLDS16(bq_ + BQ2, so_ + dstB + 2048); GLDS16(bq_ + BQ3, so_ + dstB + 3072); }
        __builtin_amdgcn_sched_barrier(0);
#pragma unroll
        for (int j = 0; j < 8; ++j)
#pragma unroll
            for (int i = 0; i < 4; ++i) acc[i][j] = __builtin_amdgcn_mfma_f32_16x16x32_bf16(bfr[j], af[i], acc[i][j], 0, 0, 0);
        nx2 = cur; cur = (cur == 2 * GEMM_STAGE) ? 0 : cur + GEMM_STAGE;
    }
    __syncthreads();
#undef GEMM_STAGE_LOAD
    epi(acc, m0 + wm * 64, n0 + wn * 128, lane, lds);
}

struct EpiProj {
    static constexpr bool PERM = true;
    bf16_t* out;
    __device__ __forceinline__ void operator()(f32x4 (&acc)[4][8], int mb, int nb, int lane, char*) {
#pragma unroll
        for (int g = 0; g < 4; ++g) {
            const int col = nb + g * 32 + (lane >> 4) * 8;
            const float sc = (col < 512 || (col >= 1536 && col < 2048)) ? QSCALE : 1.0f;
#pragma unroll
            for (int i = 0; i < 4; ++i) {
                const int row = mb + i * 16 + (lane & 15);
                const f32x4 a = acc[i][2 * g], c = acc[i][2 * g + 1];
                u32x4 w; w.x = cvtpk(a[0] * sc, a[1] * sc); w.y = cvtpk(a[2] * sc, a[3] * sc); w.z = cvtpk(c[0] * sc, c[1] * sc); w.w = cvtpk(c[2] * sc, c[3] * sc);
                *(u32x4*)(out + (size_t)row * INW + col) = w;
            }
        }
    }
};


constexpr int ATT_WS = 69632;
constexpr int ATT_LDS = ATT_WS + 4 * 256;
#define MFMA32(a, b, c) __builtin_amdgcn_mfma_f32_32x32x16_bf16(a, b, c, 0, 0, 0)
typedef short v4i16_t __attribute__((ext_vector_type(4)));
typedef __attribute__((address_space(3))) const char* lds_cptr;
__device__ __forceinline__ s16x4 vtr(const char* p) { return __builtin_bit_cast(s16x4, __builtin_amdgcn_ds_read_tr16_b64_v4i16((__attribute__((address_space(3))) v4i16_t*)(lds_cptr)p)); }
__device__ __forceinline__ int crow(int r, int hi) { return (r & 3) + 8 * (r >> 2) + 4 * hi; }
__device__ __forceinline__ float max3f(float a, float b, float c) { float r; asm("v_max3_f32 %0, %1, %2, %3" : "=v"(r) : "v"(a), "v"(b), "v"(c)); return r; }
__device__ __forceinline__ float rowmax32(const f32x16& p0, const f32x16& p1) {
    float x0 = p0[0], x1 = p1[0]; asm volatile("s_nop 7\n\ts_nop 3" : "+v"(x0), "+v"(x1));
    float a = max3f(x0, p0[1], p0[2]), b = max3f(x1, p1[1], p1[2]);
#pragma unroll
    for (int r = 3; r < 15; r += 2) { a = max3f(a, p0[r], p0[r + 1]); b = max3f(b, p1[r], p1[r + 1]); }
    a = max3f(a, p0[15], b); a = fmaxf(a, p1[15]);
    auto rr = __builtin_amdgcn_permlane32_swap(__float_as_uint(a), __float_as_uint(a), false, false);
    return fmaxf(__uint_as_float(rr[0]), __uint_as_float(rr[1]));
}

struct VFrag { u32x2 lo, hh; };
#define VTR1(dst, va, OFF) asm volatile("ds_read_b64_tr_b16 %0, %1 offset:%2" : "=v"(dst) : "v"(va), "n"(OFF) : "memory")
template <int DV, int KS>
__device__ __forceinline__ void vload(VFrag (&f)[DV / 32], unsigned va) {
    constexpr int KBS = (DV / 32) * 512;
    VTR1(f[0].lo, va, (2 * KS) * KBS); VTR1(f[0].hh, va, (2 * KS + 1) * KBS);
    VTR1(f[1].lo, va, (2 * KS) * KBS + 512); VTR1(f[1].hh, va, (2 * KS + 1) * KBS + 512);
    if constexpr (DV == 128) {
        VTR1(f[2].lo, va, (2 * KS) * KBS + 1024); VTR1(f[2].hh, va, (2 * KS + 1) * KBS + 1024);
        VTR1(f[3].lo, va, (2 * KS) * KBS + 1536); VTR1(f[3].hh, va, (2 * KS + 1) * KBS + 1536);
    }
}
template <int DV, int N>
__device__ __forceinline__ void vwait(VFrag (&f)[DV / 32]) {
    if constexpr (DV == 128) asm volatile("s_waitcnt lgkmcnt(%8)" : "+v"(f[0].lo), "+v"(f[0].hh), "+v"(f[1].lo), "+v"(f[1].hh), "+v"(f[2].lo), "+v"(f[2].hh), "+v"(f[3].lo), "+v"(f[3].hh) : "n"(N));
    else asm volatile("s_waitcnt lgkmcnt(%4)" : "+v"(f[0].lo), "+v"(f[0].hh), "+v"(f[1].lo), "+v"(f[1].hh) : "n"(N));
}
template <int DV, int KS>
__device__ __forceinline__ void pv_step(VFrag (&cur)[DV / 32], VFrag (&nxt)[DV / 32], unsigned va, const u32x4& pw, f32x16 (&o)[DV / 32]) {
    if constexpr (KS < 3) { vload<DV, KS + 1>(nxt, va); vwait<DV, 2 * (DV / 32)>(cur); } else vwait<DV, 0>(cur);
    const bf16x8 pa = __builtin_bit_cast(bf16x8, pw);
#pragma unroll
    for (int db = 0; db < DV / 32; ++db) {
        const u32x4 w = (u32x4){cur[db].lo.x, cur[db].lo.y, cur[db].hh.x, cur[db].hh.y};
        o[db] = MFMA32(pa, __builtin_bit_cast(bf16x8, w), o[db]);
    }
}
template <int DV, int MODE>
__device__ __forceinline__ void attn_tile(const char* kimg, const char* vimg, const bf16x8 (&qr)[4], f32x16 (&o)[DV / 32], float& m, float& l, int k0, int qpos, float slope2,
                                          bool need_mask, float* wsf, int r32, int hi, int lane) {
    const char* kp = kimg + r32 * 128; const int kx = (r32 >> 1) & 7;
    const unsigned va = (unsigned)(size_t)(lds_cptr)(vimg + ((lane >> 4) & 1) * 32 + (lane & 3) * 8 + (4 * hi + ((lane & 15) >> 2)) * 64);
    VFrag va0[DV / 32], va1[DV / 32];
    vload<DV, 0>(va0, va);
    const float base0 = slope2 * (float)(k0 + 4 * hi - qpos) - m;
    f32x16 c0, c1;
#pragma unroll
    for (int r = 0; r < 16; ++r) { const float cst = (float)((r & 3) + 8 * (r >> 2)); c0[r] = fmaf(slope2, cst, base0); c1[r] = fmaf(slope2, cst + 32.0f, base0); }
    bf16x8 kf[8];
#pragma unroll
    for (int d0 = 0; d0 < 4; ++d0) { const int po = ((2 * d0 + hi) ^ kx) * 16; kf[2 * d0] = *(const bf16x8*)(kp + po); kf[2 * d0 + 1] = *(const bf16x8*)(kp + 4096 + po); }
    __builtin_amdgcn_sched_barrier(0);
#pragma unroll
    for (int d0 = 0; d0 < 4; ++d0) { c0 = MFMA32(kf[2 * d0], qr[d0], c0); c1 = MFMA32(kf[2 * d0 + 1], qr[d0], c1); }
    if (need_mask) {
        const int kb = k0 + 4 * hi;
#pragma unroll
        for (int r = 0; r < 16; ++r) {
            const int key = kb + (r & 3) + 8 * (r >> 2);
            bool v0 = key <= qpos, v1 = key + 32 <= qpos;
            if (MODE == 1) { v0 = v0 && (key > qpos - 128); v1 = v1 && (key + 32 > qpos - 128); }
            c0[r] = v0 ? c0[r] : -INFINITY; c1[r] = v1 ? c1[r] : -INFINITY;
        }
    }
    const float rm = rowmax32(c0, c1);
    if (__any(rm > 8.0f)) {
        const float delta = fmaxf(rm, 0.f); m += delta; const float alpha = exp2f(-delta); l *= alpha;
#pragma unroll
        for (int r = 0; r < 16; ++r) { c0[r] -= delta; c1[r] -= delta; }
        if (hi == 0) wsf[r32] = alpha;
        __builtin_amdgcn_s_waitcnt(0xc07f);
        int q4 = 4 * hi; asm volatile("" : "+v"(q4));
        const float* wb = wsf + q4;
#pragma unroll
        for (int r = 0; r < 16; ++r) { const float a = wb[(r & 3) + 8 * (r >> 2)];
#pragma unroll
            for (int db = 0; db < DV / 32; ++db) o[db][r] *= a; }
    }
#pragma unroll
    for (int r = 0; r < 16; ++r) { c0[r] = __builtin_amdgcn_exp2f(c0[r]); c1[r] = __builtin_amdgcn_exp2f(c1[r]); }
    {
        typedef float f32x2 __attribute__((ext_vector_type(2)));
        f32x2 t[8];
#pragma unroll
        for (int r = 0; r < 8; ++r) t[r] = (f32x2){c0[2 * r], c0[2 * r + 1]} + (f32x2){c1[2 * r], c1[2 * r + 1]};
#pragma unroll
        for (int r = 0; r < 4; ++r) t[r] = t[r] + t[r + 4];
        t[0] = (t[0] + t[2]) + (t[1] + t[3]);
        l += t[0].x + t[0].y;
    }
    u32x4 pw[4];
#pragma unroll
    for (int s = 0; s < 2; ++s) {
        pw[s] = (u32x4){cvtpk(c0[8 * s], c0[8 * s + 1]), cvtpk(c0[8 * s + 2], c0[8 * s + 3]), cvtpk(c0[8 * s + 4], c0[8 * s + 5]), cvtpk(c0[8 * s + 6], c0[8 * s + 7])};
        pw[2 + s] = (u32x4){cvtpk(c1[8 * s], c1[8 * s + 1]), cvtpk(c1[8 * s + 2], c1[8 * s + 3]), cvtpk(c1[8 * s + 4], c1[8 * s + 5]), cvtpk(c1[8 * s + 6], c1[8 * s + 7])};
    }
    pv_step<DV, 0>(va0, va1, va, pw[0], o);
    pv_step<DV, 1>(va1, va0, va, pw[1], o);
    pv_step<DV, 2>(va0, va1, va, pw[2], o);
    pv_step<DV, 3>(va1, va0, va, pw[3], o);
}

template <int DV>
__device__ __forceinline__ void attn_finish(f32x16 (&o)[DV / 32], float l, float extra, float* wsf, float* ost, int r32, int hi) {
    auto rr = __builtin_amdgcn_permlane32_swap(__float_as_uint(l), __float_as_uint(l), false, false);
    const float lt = __uint_as_float(rr[0]) + __uint_as_float(rr[1]) + extra;
    if (hi == 0) wsf[32 + r32] = 1.0f / lt;
    __builtin_amdgcn_s_waitcnt(0xc07f);
    int q4 = 4 * hi; asm volatile("" : "+v"(q4));
    const float* wb = wsf + 32 + q4; float* ob = ost + q4 * (DV + 4) + r32;
#pragma unroll
    for (int r = 0; r < 16; ++r) { const int qc = (r & 3) + 8 * (r >> 2); const float a = wb[qc];
#pragma unroll
        for (int db = 0; db < DV / 32; ++db) ob[qc * (DV + 4) + db * 32] = o[db][r] * a; }
}

__device__ __forceinline__ void diff_unit(const Params& p, int b, int h, int qblk, float lam) {
    const int tid = opaque_tid(), lane = tid & 63, wid = wave_of(tid), r32 = lane & 31, hi = lane >> 5, map = wid >> 1, chunk = wid & 1;
    const bf16_t* base = p.proj + (size_t)b * S * INW;
    const int q0 = qblk * 64 + chunk * 32, qpos = q0 + r32;
    const float slope2 = exp2f(-8.0f * (float)(9 + h) / 12.0f) * LOG2E;
    float* wsf = (float*)(smem + ATT_WS) + wid * 64;
    bf16x8 qr[4];
    { const bf16_t* qp = base + (size_t)qpos * INW + h * 128 + map * 64 + hi * 8;
#pragma unroll
      for (int d0 = 0; d0 < 4; ++d0) qr[d0] = *(const bf16x8*)(qp + d0 * 16); }
    f32x16 o[4];
#pragma unroll
    for (int db = 0; db < 4; ++db) o[db] = f32x16{};
    float m = 0.f, l = 0.f;
    const int kc0 = ((lane & 7) ^ (lane >> 4)) * 8;
    const bf16_t* kg = base + (size_t)(32 * (wid & 1) + (lane >> 3)) * INW + 512 + h * 128 + (wid >> 1) * 64;
    const bf16_t* vg = base + (size_t)(32 * (wid & 1) + ((lane >> 2) & 7)) * INW + 1024 + h * 128 + (wid >> 1) * 64 + (lane >> 5) * 32 + (lane & 3) * 8;
    const int kdst = (wid >> 1) * 8192 + (wid & 1) * 4096, vdst = 16384 + (wid & 1) * 8192 + (wid >> 1) * 1024;
    const int nt = qblk + 1;
#define GLDS(gp, off) __builtin_amdgcn_global_load_lds((const unsigned*)(gp), (__attribute__((address_space(3))) unsigned*)(smem + (off)), 16, 0, 0)
#define DIFF_STAGE(t, st) do { const size_t go = (size_t)(t) * 64 * INW; const int sb_ = (st) * 32768; \
        GLDS(kg + go + kc0, sb_ + kdst); GLDS(kg + go + (size_t)8 * INW + (kc0 ^ 32), sb_ + kdst + 1024); \
        GLDS(kg + go + (size_t)16 * INW + kc0, sb_ + kdst + 2048); GLDS(kg + go + (size_t)24 * INW + (kc0 ^ 32), sb_ + kdst + 3072); \
        _Pragma("unroll") for (int kb = 0; kb < 4; ++kb) GLDS(vg + go + (size_t)kb * 8 * INW, sb_ + vdst + kb * 2048); } while (0)
    DIFF_STAGE(0, 0);
    __syncthreads();
    for (int t = 0; t < nt; ++t) {
        if (t + 1 < nt) DIFF_STAGE(t + 1, (t + 1) & 1);
        const char* sb = smem + (t & 1) * 32768;
        attn_tile<128, 0>(sb + map * 8192, sb + 16384, qr, o, m, l, t * 64, qpos, slope2, t * 64 + 63 > q0, wsf, r32, hi, lane);
        __syncthreads();
    }
#undef DIFF_STAGE
    float* ost = (float*)smem + wid * (32 * 132);
    attn_finish<128>(o, l, 0.f, wsf, ost, r32, hi);
    __syncthreads();
    {
        int tq = tid; asm volatile("" : "+v"(tq));
        const int q = tq >> 2, dq = tq & 3, ch = q >> 5, qi = q & 31;
        const float* o1 = (const float*)smem + ch * (32 * 132) + qi * 132 + dq * 32;
        const float* o2 = (const float*)smem + (2 + ch) * (32 * 132) + qi * 132 + dq * 32;
        float v[32]; float ss = 0.f;
#pragma unroll
        for (int i = 0; i < 8; ++i) { const f32x4 a = *(const f32x4*)(o1 + 4 * i), c = *(const f32x4*)(o2 + 4 * i);
#pragma unroll
            for (int e = 0; e < 4; ++e) { const float x = a[e] - lam * c[e]; v[4 * i + e] = x; ss += x * x; } }
        ss += __shfl_xor(ss, 1); ss += __shfl_xor(ss, 2);
        const float rn = rsqrtf(ss * (1.0f / 128.0f) + LN_EPS) * (1.0f - LAMBDA_INIT);
        const float* g = p.subln_g + dq * 32;
        bf16_t* op = p.attn + tm_act(b * S + qblk * 64 + q, h * 128 + dq * 32);
#pragma unroll
        for (int i = 0; i < 4; ++i) { u32x4 w;
            w.x = cvtpk(v[8 * i] * rn * g[8 * i], v[8 * i + 1] * rn * g[8 * i + 1]); w.y = cvtpk(v[8 * i + 2] * rn * g[8 * i + 2], v[8 * i + 3] * rn * g[8 * i + 3]);
            w.z = cvtpk(v[8 * i + 4] * rn * g[8 * i + 4], v[8 * i + 5] * rn * g[8 * i + 5]); w.w = cvtpk(v[8 * i + 6] * rn * g[8 * i + 6], v[8 * i + 7] * rn * g[8 * i + 7]);
            *(u32x4*)(op + 8 * i) = w; }
    }
    __syncthreads();
}

__device__ __forceinline__ void swa_unit(const Params& p, int b, int kv, int qc) {
    const int tid = opaque_tid(), lane = tid & 63, wid = wave_of(tid), r32 = lane & 31, hi = lane >> 5, hq = kv * 4 + wid;
    const bf16_t* base = p.proj + (size_t)b * S * INW;
    const int q0 = qc * 32, qpos = q0 + r32;
    const float slope2 = exp2f(-8.0f * (float)(1 + hq) / 12.0f) * LOG2E;
    float* wsf = (float*)(smem + ATT_WS) + wid * 64;
    bf16x8 qr[4];
    { const bf16_t* qp = base + (size_t)qpos * INW + 1536 + hq * 64 + hi * 8;
#pragma unroll
      for (int d0 = 0; d0 < 4; ++d0) qr[d0] = *(const bf16x8*)(qp + d0 * 16); }
    f32x16 o[2]; o[0] = f32x16{}; o[1] = f32x16{};
    float m = 0.f, l = 0.f;
    const int kc0 = ((lane & 7) ^ (lane >> 4)) * 8;
    const bf16_t* kg = base + (size_t)(16 * wid + (lane >> 3)) * INW + 2048 + kv * 64;
    const bf16_t* vg = base + (size_t)(16 * wid + ((lane >> 2) & 7)) * INW + 2176 + kv * 64 + (lane >> 5) * 32 + (lane & 3) * 8;
    const int t_lo = (q0 - 127 > 0 ? q0 - 127 : 0) >> 6, t_hi = (q0 + 31) >> 6;
#define SWA_STAGE(t, st) do { const size_t go = (size_t)(t) * 64 * INW; const int sb_ = (st) * 32768; \
        GLDS(kg + go + kc0, sb_ + wid * 2048); GLDS(kg + go + (size_t)8 * INW + (kc0 ^ 32), sb_ + wid * 2048 + 1024); \
        GLDS(vg + go, sb_ + 16384 + wid * 2048); GLDS(vg + go + (size_t)8 * INW, sb_ + 16384 + wid * 2048 + 1024); } while (0)
    SWA_STAGE(t_lo, 0);
    __syncthreads();
    for (int t = t_lo; t <= t_hi; ++t) {
        const int st = (t - t_lo) & 1;
        if (t < t_hi) SWA_STAGE(t + 1, st ^ 1);
        const char* sb = smem + st * 32768;
        attn_tile<64, 1>(sb, sb + 16384, qr, o, m, l, t * 64, qpos, slope2, true, wsf, r32, hi, lane);
        __syncthreads();
    }
#undef SWA_STAGE
    float* ost = (float*)smem + wid * (32 * 68);
    attn_finish<64>(o, l, exp2f(p.sinks[hq] * LOG2E - m), wsf, ost, r32, hi);
    __syncthreads();
    {
        int tq = tid; asm volatile("" : "+v"(tq));
        const int q = tq >> 3, g = (tq >> 1) & 3, dh = tq & 1;
        const float* os = (const float*)smem + g * (32 * 68) + q * 68 + dh * 32;
        bf16_t* op = p.attn + tm_act(b * S + q0 + q, 512 + (kv * 4 + g) * 64 + dh * 32);
#pragma unroll
        for (int i = 0; i < 4; ++i) { const f32x4 a = *(const f32x4*)(os + 8 * i), c = *(const f32x4*)(os + 8 * i + 4);
            u32x4 w; w.x = cvtpk(a[0], a[1]); w.y = cvtpk(a[2], a[3]); w.z = cvtpk(c[0], c[1]); w.w = cvtpk(c[2], c[3]);
            *(u32x4*)(op + 8 * i) = w; }
    }
    __syncthreads();
}

constexpr int ATT_ITEMS = 4096;
__device__ __forceinline__ void attn_item(const Params& p, int item, float lam) {
    if (item < 2048) {
        const int bh = item >> 4, j = item & 15, b = bh >> 2, h = bh & 3;
        diff_unit(p, b, h, 31 - j, lam);
        diff_unit(p, b, h, j, lam);
    } else {
        const int it = item - 2048, bkv = it >> 5, qq = it & 31, b = bkv >> 1, kv = bkv & 1;
        swa_unit(p, b, kv, 2 * qq);
        swa_unit(p, b, kv, 2 * qq + 1);
    }
}

struct EpiY1 {
    static constexpr bool PERM = true;
    const float* x; const float* mod; bf16_t* y;
    __device__ __forceinline__ void operator()(f32x4 (&acc)[4][8], int mb, int nb, int lane, char*) {
        const int b = mb / S;
        const float* xb = x + (size_t)(mb + (lane & 15)) * D + nb + (lane >> 4) * 8;
        const float* gb = mod + b * MODW + G1 + nb + (lane >> 4) * 8;
        bf16_t* yb = y + (size_t)(mb + (lane & 15)) * D + nb + (lane >> 4) * 8;
        f32x4 xv[2][4][2], gv[2][2];
#define Y1_LD(dst, ptr) asm volatile("global_load_dwordx4 %0, %1, off" : "=v"(dst) : "v"(ptr))
#define Y1_ISSUE(s, g) do { Y1_LD(gv[s][0], gb + (g) * 32); Y1_LD(gv[s][1], gb + (g) * 32 + 4); \
        _Pragma("unroll") for (int i_ = 0; i_ < 4; ++i_) { Y1_LD(xv[s][i_][0], xb + (g) * 32 + (size_t)i_ * 16 * D); Y1_LD(xv[s][i_][1], xb + (g) * 32 + (size_t)i_ * 16 * D + 4); } } while (0)
#define Y1_TIE(s) "+v"(gv[s][0]), "+v"(gv[s][1]), "+v"(xv[s][0][0]), "+v"(xv[s][0][1]), "+v"(xv[s][1][0]), "+v"(xv[s][1][1]), "+v"(xv[s][2][0]), "+v"(xv[s][2][1]), "+v"(xv[s][3][0]), "+v"(xv[s][3][1])
        Y1_ISSUE(0, 0);
#pragma unroll
        for (int g = 0; g < 4; ++g) {
            const int s = g & 1;
            if (g < 3) { Y1_ISSUE(s ^ 1, g + 1);
                if (s == 0) asm volatile("s_waitcnt vmcnt(10)" : Y1_TIE(0)); else asm volatile("s_waitcnt vmcnt(10)" : Y1_TIE(1)); }
            else asm volatile("s_waitcnt vmcnt(0)" : Y1_TIE(1));
#pragma unroll
            for (int i = 0; i < 4; ++i) {
                const f32x4 y0 = xv[s][i][0] * ALPHA + gv[s][0] * acc[i][2 * g], y1v = xv[s][i][1] * ALPHA + gv[s][1] * acc[i][2 * g + 1];
                u32x4 w; w.x = cvtpk(y0[0], y0[1]); w.y = cvtpk(y0[2], y0[3]); w.z = cvtpk(y1v[0], y1v[1]); w.w = cvtpk(y1v[2], y1v[3]);
                *(u32x4*)(yb + g * 32 + (size_t)i * 16 * D) = w;
            }
        }
#undef Y1_TIE
#undef Y1_ISSUE
#undef Y1_LD
    }
};

#define DPP_ADD(v, ctrl) ((v) + __int_as_float(__builtin_amdgcn_update_dpp(0, __float_as_int(v), (ctrl), 0xf, 0xf, false)))
__device__ __forceinline__ float wave_sum(float v) {
    v = DPP_ADD(v, 0xB1);
    v = DPP_ADD(v, 0x4E);
    v = DPP_ADD(v, 0x141);
    v = DPP_ADD(v, 0x140);
    { auto r = __builtin_amdgcn_permlane16_swap(__float_as_uint(v), __float_as_uint(v), false, false); v = __uint_as_float(r[0]) + __uint_as_float(r[1]); }
    { auto r = __builtin_amdgcn_permlane32_swap(__float_as_uint(v), __float_as_uint(v), false, false); v = __uint_as_float(r[0]) + __uint_as_float(r[1]); }
    return v;
}

#define DPP_MAX(v, ctrl) fmaxf((v), __int_as_float(__builtin_amdgcn_update_dpp(0, __float_as_int(v), (ctrl), 0xf, 0xf, false)))
__device__ __forceinline__ float wave_max(float v) {
    v = DPP_MAX(v, 0xB1); v = DPP_MAX(v, 0x4E); v = DPP_MAX(v, 0x141); v = DPP_MAX(v, 0x140);
    { auto r = __builtin_amdgcn_permlane16_swap(__float_as_uint(v), __float_as_uint(v), false, false); v = fmaxf(__uint_as_float(r[0]), __uint_as_float(r[1])); }
    { auto r = __builtin_amdgcn_permlane32_swap(__float_as_uint(v), __float_as_uint(v), false, false); v = fmaxf(__uint_as_float(r[0]), __uint_as_float(r[1])); }
    return v;
}
__device__ __forceinline__ void ln1_rows(const Params& p, int r0) {
    const int tid = opaque_tid(), lane = tid & 63, wid = wave_of(tid), b = r0 / S;
    f32x4 g[4], be[4], sc[4], sh[4];
#pragma unroll
    for (int v = 0; v < 4; ++v) { const int c = 8 * lane + 512 * (v >> 1) + 4 * (v & 1); g[v] = *(const f32x4*)(p.ln1_g + c); be[v] = *(const f32x4*)(p.ln1_b + c);
        sc[v] = *(const f32x4*)(p.mod + b * MODW + SC2 + c); sh[v] = *(const f32x4*)(p.mod + b * MODW + SH2 + c); }
    u32x4 yw[4][2];
    const bf16_t* yb = p.y1 + (size_t)(r0 + wid * 32) * D + 8 * lane;
#define LN_LD(dst, ptr) asm volatile("global_load_dwordx4 %0, %1, off" : "=v"(dst) : "v"(ptr))
#define LN_ISSUE(s, row) do { const bf16_t* yp_ = yb + (size_t)(row) * D; LN_LD(yw[s][0], yp_); LN_LD(yw[s][1], yp_ + 512); } while (0)
    LN_ISSUE(0, 0); LN_ISSUE(1, 1);
#pragma unroll 1
    for (int i0 = 0; i0 < 32; i0 += 4) {
#pragma unroll
      for (int r = 0; r < 4; ++r) {
        const int i = i0 + r;
        { const int nx = (i + 2 < 32) ? i + 2 : 31; LN_ISSUE((r + 2) & 3, nx); }
        asm volatile("s_waitcnt vmcnt(4)" : "+v"(yw[r][0]), "+v"(yw[r][1]));
        const size_t ro = (size_t)(r0 + wid * 32 + i) * D;
        f32x4 v[4]; float s = 0.f;
#pragma unroll
        for (int j = 0; j < 2; ++j) { const u32x4 w4 = yw[r][j];
            v[2 * j] = (f32x4){bflo(w4.x), bfhi(w4.x), bflo(w4.y), bfhi(w4.y)}; v[2 * j + 1] = (f32x4){bflo(w4.z), bfhi(w4.z), bflo(w4.w), bfhi(w4.w)}; }
#pragma unroll
        for (int k = 0; k < 4; ++k) s += (v[k][0] + v[k][1]) + (v[k][2] + v[k][3]);
        const float mu = wave_sum(s) * (1.0f / D);
        float q = 0.f;
#pragma unroll
        for (int k = 0; k < 4; ++k) { v[k] = v[k] - mu; q += (v[k][0] * v[k][0] + v[k][1] * v[k][1]) + (v[k][2] * v[k][2] + v[k][3] * v[k][3]); }
        const float rs = rsqrtf(wave_sum(q) * (1.0f / D) + LN_EPS);
        u32x4 hw2[2];
#pragma unroll
        for (int j = 0; j < 2; ++j) {
            const f32x4 xo0 = v[2 * j] * rs * g[2 * j] + be[2 * j], xo1 = v[2 * j + 1] * rs * g[2 * j + 1] + be[2 * j + 1];
            u32x4 xw; xw.x = cvtpk(xo0[0], xo0[1]); xw.y = cvtpk(xo0[2], xo0[3]); xw.z = cvtpk(xo1[0], xo1[1]); xw.w = cvtpk(xo1[2], xo1[3]);
            *(u32x4*)(p.x1 + ro + 8 * lane + 512 * j) = xw;
            const f32x4 h0 = xo0 * (sc[2 * j] + 1.0f) + sh[2 * j], h1 = xo1 * (sc[2 * j + 1] + 1.0f) + sh[2 * j + 1];
            u32x4 w; w.x = cvtpk(h0[0], h0[1]); w.y = cvtpk(h0[2], h0[3]); w.z = cvtpk(h1[0], h1[1]); w.w = cvtpk(h1[2], h1[3]);
            *(u32x4*)(p.hbuf + tm_act(r0 + wid * 32 + i, 8 * lane + 512 * j)) = w;
            hw2[j] = w;
        }
        {
            float am = 0.f;
#pragma unroll
            for (int j = 0; j < 2; ++j)
#pragma unroll
                for (int q = 0; q < 4; ++q) am = fmaxf(am, fmaxf(fabsf(bflo(hw2[j][q])), fabsf(bfhi(hw2[j][q]))));
            am = wave_max(am);
            am = fmaxf(am, 1e-30f); const float inv = 119.0f / am;
#pragma unroll
            for (int j = 0; j < 2; ++j) {
                unsigned pa = 0u, pb = 0u;
#pragma unroll
                for (int q = 0; q < 4; ++q) {
                    const int x0 = (int)rintf(bflo(hw2[j][q]) * inv), x1 = (int)rintf(bfhi(hw2[j][q]) * inv);
                    const int b0 = ((x0 + 8) & 15) - 8, b1 = ((x1 + 8) & 15) - 8, a0 = (x0 - b0) >> 4, a1 = (x1 - b1) >> 4;
                    pa |= ((unsigned)a0 & 15u) << (8 * q); pa |= ((unsigned)a1 & 15u) << (8 * q + 4); pb |= ((unsigned)b0 & 15u) << (8 * q); pb |= ((unsigned)b1 & 15u) << (8 * q + 4);
                }
                unsigned* hp = p.hq + (size_t)(r0 + wid * 32 + i) * 256 + ((lane >> 2) + 16 * j) * 8 + (lane & 3);
                hp[0] = pa; hp[4] = pb;
            }
            if (lane == 0) p.hsc[r0 + wid * 32 + i] = am * (1.0f / 119.0f);
        }
      }
    }
    asm volatile("s_waitcnt vmcnt(0)" ::: "memory");
#undef LN_ISSUE
#undef LN_LD
}

__device__ __forceinline__ int f2ord(float v) { const int u = __float_as_int(v); return u ^ ((u >> 31) & 0x7fffffff); }
__device__ __forceinline__ float ord2f(int k) { return __int_as_float(k ^ ((k >> 31) & 0x7fffffff)); }
__device__ __forceinline__ void cex(int& a, int& b) { const int mx = max(a, b), mn = min(a, b); a = mx; b = mn; }
__device__ __forceinline__ void sort16_desc(int (&a)[16]) {
#pragma unroll
    for (int k = 2; k <= 16; k <<= 1)
#pragma unroll
        for (int j = k >> 1; j > 0; j >>= 1)
#pragma unroll
            for (int i = 0; i < 16; ++i) { const int l = i ^ j; if (l > i) { if ((i & k) == 0) cex(a[i], a[l]); else cex(a[l], a[i]); } }
}
__device__ __forceinline__ void merge16_desc(int (&a)[16]) {
#pragma unroll
    for (int j = 8; j > 0; j >>= 1)
#pragma unroll
        for (int i = 0; i < 16; ++i) { const int l = i ^ j; if (l > i) cex(a[i], a[l]); }
}
__device__ __forceinline__ void top16_merge(int (&top)[16], const int (&c)[16]) {
#pragma unroll
    for (int i = 0; i < 16; ++i) top[i] = max(top[i], c[15 - i]);
    merge16_desc(top);
}

struct EpiTopk {
    static constexpr bool PERM = false;
    int* hk; int hp0;
    __device__ __forceinline__ void operator()(f32x4 (&acc)[4][8], int mb, int nb, int lane, char* lds) {
        const int tid = opaque_tid(), wid = wave_of(tid), wm = wid >> 1, wn = wid & 1;
#pragma unroll 1
        for (int pass = 0; pass < 2; ++pass) {
            if (wn == pass) {
#pragma unroll
                for (int i = 0; i < 4; ++i) {
                    const int row = wm * 64 + i * 16 + (lane & 15);
#pragma unroll
                    for (int j = 0; j < 8; ++j) { const int c = j * 4 + (lane >> 4); *(f32x4*)(lds + row * 512 + ((c ^ (2 * (row & 7))) << 4)) = acc[i][j]; }
                }
            }
            __syncthreads();
            const int row = tid >> 1, half = tid & 1, sw = 2 * (row & 7);
            const char* rp = lds + row * 512;
            int top[16];
#pragma unroll
            for (int gq = 0; gq < 4; ++gq) {
                int c[16];
#pragma unroll
                for (int ii = 0; ii < 4; ++ii) {
                    const int ch = 2 * (4 * gq + ii) + half;
                    const f32x4 v = *(const f32x4*)(rp + ((ch ^ sw) << 4));
#pragma unroll
                    for (int e = 0; e < 4; ++e) c[4 * ii + e] = (f2ord(v[e]) & ~127) | (127 - (ch * 4 + e));
                }
                sort16_desc(c);
                if (gq == 0) {
#pragma unroll
                    for (int i = 0; i < 16; ++i) top[i] = c[i];
                } else top16_merge(top, c);
            }
            int oth[16];
#pragma unroll
            for (int i = 0; i < 16; ++i) oth[i] = __shfl_xor(top[15 - i], 1);
#pragma unroll
            for (int i = 0; i < 16; ++i) top[i] = max(top[i], oth[i]);
            merge16_desc(top);
            if (half == 0) {
                int* op = hk + ((size_t)(mb - wm * 64 + row) * 16 + hp0 + pass) * 16;
#pragma unroll
                for (int i = 0; i < 4; ++i) *(u32x4*)(op + 4 * i) = (u32x4){(unsigned)top[4 * i], (unsigned)top[4 * i + 1], (unsigned)top[4 * i + 2], (unsigned)top[4 * i + 3]};
            }
            __syncthreads();
        }
    }
};

__device__ __forceinline__ void route_combine(const Params& p, int r0) {
    const int tid = opaque_tid();
    for (int it = 0; it < 4; ++it) {
        const int th = it * 256 + tid, t = r0 + (th >> 3), h = th & 7;
        const int* ka = p.hk + ((size_t)t * 16 + 2 * h) * 16; const int* kb = ka + 16;
        float va[16], vb[16];
        int* lk = (int*)smem + tid * 33;
#pragma unroll
        for (int i = 0; i < 4; ++i) { const u32x4 a = *(const u32x4*)(ka + 4 * i), b = *(const u32x4*)(kb + 4 * i);
#pragma unroll
            for (int e = 0; e < 4; ++e) { va[4 * i + e] = ord2f((int)a[e] & ~127); vb[4 * i + e] = ord2f((int)b[e] & ~127);
                lk[4 * i + e] = (127 - ((int)a[e] & 127)) * 128; lk[16 + 4 * i + e] = 127 - ((int)b[e] & 127); } }
        int top[16];
        {
            int c[16];
#pragma unroll
            for (int j = 0; j < 16; ++j) c[j] = (f2ord(va[0] + vb[j]) & ~255) | (255 - j);
            sort16_desc(c);
#pragma unroll
            for (int i = 0; i < 16; ++i) top[i] = c[i];
#pragma unroll
            for (int j = 0; j < 8; ++j) c[j] = (f2ord(va[1] + vb[j]) & ~255) | (255 - (16 + j));
#pragma unroll
            for (int j = 0; j < 5; ++j) c[8 + j] = (f2ord(va[2] + vb[j]) & ~255) | (255 - (32 + j));
#pragma unroll
            for (int j = 0; j < 3; ++j) c[13 + j] = (f2ord(va[3] + vb[j]) & ~255) | (255 - (48 + j));
            sort16_desc(c); top16_merge(top, c);
            c[0] = (f2ord(va[3] + vb[3]) & ~255) | (255 - (48 + 3));
#pragma unroll
            for (int j = 0; j < 3; ++j) c[1 + j] = (f2ord(va[4] + vb[j]) & ~255) | (255 - (64 + j));
#pragma unroll
            for (int i = 5; i < 8; ++i)
#pragma unroll
                for (int j = 0; j < 2; ++j) c[4 + (i - 5) * 2 + j] = (f2ord(va[i] + vb[j]) & ~255) | (255 - (16 * i + j));
#pragma unroll
            for (int i = 8; i < 14; ++i) c[10 + (i - 8)] = (f2ord(va[i] + vb[0]) & ~255) | (255 - (16 * i));
            sort16_desc(c); top16_merge(top, c);
            c[0] = (f2ord(va[14] + vb[0]) & ~255) | (255 - 16 * 14); c[1] = (f2ord(va[15] + vb[0]) & ~255) | (255 - 16 * 15);
            cex(c[0], c[1]);
#pragma unroll
            for (int i = 2; i < 16; ++i) c[i] = (int)0x80000000;
            top16_merge(top, c);
        }
        float e[16], sum = 0.f; const float s0 = ord2f(top[0] & ~255);
#pragma unroll
        for (int k = 0; k < 16; ++k) { e[k] = __expf(ord2f(top[k] & ~255) - s0); sum += e[k]; }
        const float rs = 1.0f / sum;
        int* eo = p.eidx + (size_t)t * 128 + h * 16; float* go = p.gw + (size_t)t * 128 + h * 16;
#pragma unroll
        for (int k = 0; k < 16; ++k) { const int pos = 255 - (top[k] & 255); eo[k] = lk[pos >> 4] + lk[16 + (pos & 15)]; go[k] = e[k] * rs; }
    }
}

typedef __bf16 bf16x2_t __attribute__((ext_vector_type(2)));
__device__ __forceinline__ float dot2bf(unsigned a, unsigned b, float c) { return __builtin_amdgcn_fdot2_f32_bf16(__builtin_bit_cast(bf16x2_t, a), __builtin_bit_cast(bf16x2_t, b), c, false); }
__device__ __forceinline__ float gelu_erf(float s) { return 0.5f * s * (1.0f + erff(s * 0.70710678118654752f)); }

#define DPP_IADD(v, ctrl) ((v) + __builtin_amdgcn_update_dpp(0, (v), (ctrl), 0xf, 0xf, false))
__device__ __forceinline__ int wave_isum(int v) {
    v = DPP_IADD(v, 0xB1); v = DPP_IADD(v, 0x4E); v = DPP_IADD(v, 0x141); v = DPP_IADD(v, 0x140);
    { auto r = __builtin_amdgcn_permlane16_swap((unsigned)v, (unsigned)v, false, false); v = (int)(r[0] + r[1]); }
    { auto r = __builtin_amdgcn_permlane32_swap((unsigned)v, (unsigned)v, false, false); v = (int)(r[0] + r[1]); }
    return v;
}
__device__ __forceinline__ float ub0(unsigned w) { return (float)(w & 0xffu); }
__device__ __forceinline__ float ub1(unsigned w) { return (float)((w >> 8) & 0xffu); }
__device__ __forceinline__ float ub2(unsigned w) { return (float)((w >> 16) & 0xffu); }
__device__ __forceinline__ float ub3(unsigned w) { return (float)(w >> 24); }

constexpr int PEER_LVEC = 12288;
constexpr int PEER_LDS = PEER_LVEC + 4 * 16384;
__device__ __forceinline__ void peer_u(const Params& p, int t0, int ntok, int lane) {
    const int li = lane & 31, li16 = li * 16; const bool hi = lane >= 32;
    u32x4 buf[16]; unsigned mbuf[16];
#define PEV(esel, base, j) ({ const int ea__ = __builtin_amdgcn_readlane(esel, (base) + 2 * (j)), eb__ = __builtin_amdgcn_readlane(esel, (base) + 2 * (j) + 1); hi ? eb__ : ea__; })
#define PFU(j, esel, base) do { const int ev_ = PEV(esel, base, j); const int ro_ = ev_ * 512 + li16, mo_ = ev_ * 32 + li;        \
        asm volatile("global_load_dwordx4 %0, %1, %2" : "=v"(buf[j]) : "v"(ro_), "s"(p.u_q)); \
        asm volatile("global_load_ubyte %0, %1, %2" : "=v"(mbuf[j]) : "v"(mo_), "s"(p.u_m)); } while (0)
#define MBYTE(j) ({ asm volatile("s_waitcnt vmcnt(22)" : "+v"(mbuf[j])); mbuf[j]; })
#define DATA_R(j) ({ asm volatile("s_waitcnt vmcnt(22)" : "+v"(buf[j])); buf[j]; })
#define H_LOAD(tt) do { const u32x4 ha_ = *(const u32x4*)(p.hq + (size_t)(tt) * 256 + li * 8), hb_ = *(const u32x4*)(p.hq + (size_t)(tt) * 256 + li * 8 + 4); \
            _Pragma("unroll") for (int k = 0; k < 4; ++k) { hA[k] = ha_[k]; hB[k] = hb_[k]; } hs = p.hsc[(tt)]; } while (0)
    int e0 = p.eidx[(size_t)t0 * 128 + lane], e1 = p.eidx[(size_t)t0 * 128 + 64 + lane];
#pragma unroll
    for (int j = 0; j < 16; ++j) PFU(j, e0, 0);
    unsigned hA[4], hB[4]; float hs;
    H_LOAD(t0);
    asm volatile("s_waitcnt vmcnt(0)" ::: "memory");
#pragma unroll 1
    for (int it = 0; it < ntok; ++it) {
        const int t = t0 + it;
        const int tn = (it + 1 < ntok) ? t + 1 : t;
        const int e0n = p.eidx[(size_t)tn * 128 + lane], e1n = p.eidx[(size_t)tn * 128 + 64 + lane];
        if (it) H_LOAD(t);
        const float g0 = p.gw[(size_t)t * 128 + lane], g1 = p.gw[(size_t)t * 128 + 64 + lane], us0 = p.u_sc[e0], us1 = p.u_sc[e1], vs0 = p.v_sc[e0] * 255.0f, vs1 = p.v_sc[e1] * 255.0f;
        int sA = 0, sB = 0;
#define DPPM(v, ctrl) __builtin_amdgcn_update_dpp(0, (v), (ctrl), 0xf, 0xf, false)
#define PA_BLOCK(jb, DATA, PREFETCH) do { int sq_[4]; \
            _Pragma("unroll") for (int q = 0; q < 4; ++q) { const int j_ = 4 * (jb) + q; const u32x4 dd_ = DATA(j_); int sa2_ = 0, sb2_ = 0; \
                _Pragma("unroll") for (int k = 0; k < 4; ++k) { sa2_ = __builtin_amdgcn_sdot8((int)hA[k], (int)dd_[k], sa2_, false); sb2_ = __builtin_amdgcn_sdot8((int)hB[k], (int)dd_[k], sb2_, false); } \
                sq_[q] = __mul24((sa2_ << 4) + sb2_, (int)MBYTE(j_)); PREFETCH(j_); }       \
            const int r0_ = (b0_ ? sq_[2] : sq_[0]) + DPPM(b0_ ? sq_[0] : sq_[2], 0xB1), r1_ = (b0_ ? sq_[3] : sq_[1]) + DPPM(b0_ ? sq_[1] : sq_[3], 0xB1); \
            int u_ = (b1_ ? r1_ : r0_) + DPPM(b1_ ? r0_ : r1_, 0x4E);              \
            u_ += DPPM(u_, 0x124); u_ += DPPM(u_, 0x128);                         \
            { auto r_ = __builtin_amdgcn_permlane16_swap((unsigned)u_, (unsigned)u_, false, false); u_ = (int)(r_[0] + r_[1]); }     \
            { auto r_ = __builtin_amdgcn_permlane32_swap((unsigned)u_, (unsigned)u_, false, false); const int lo_ = (int)r_[0], hi_ = (int)r_[1];    \
                \
              const int gl_ = b2_ ? DPPM(lo_, 0xF5) : DPPM(lo_, 0xA0), gh_ = b2_ ? DPPM(hi_, 0xF5) : DPPM(hi_, 0xA0); \
              const int val_ = b0_ ? gh_ : gl_; sT = ((lrel >> 3) == (jb)) ? val_ : sT; } \
            __builtin_amdgcn_sched_barrier(0); } while (0)
#pragma unroll 1
        for (int g = 0; g < 4; ++g) {
            int lane_ = lane; asm volatile("" : "+v"(lane_));
            int en_ = (g == 0) ? e0 : ((g == 3) ? e0n : e1); asm volatile("" : "+v"(en_));
            const int nb_ = (g & 1) ? 0 : 32;
            int sT = (g < 2) ? sA : sB;
            const bool b0_ = lane_ & 1, b1_ = lane_ & 2, b2_ = lane_ & 4;
            const int lrel = lane_ - 32 * (g & 1);
#define PF(j) PFU(j, en_, nb_)
#pragma unroll
            for (int jb = 0; jb < 4; ++jb) PA_BLOCK(jb, DATA_R, PF);
#undef PF
            if (g < 2) sA = sT; else sB = sT;
        }
#undef PA_BLOCK
#undef DPPM
        p.gw[(size_t)t * 128 + lane] = g0 * gelu_erf((float)sA * (hs * us0)) * vs0;
        p.gw[(size_t)t * 128 + 64 + lane] = g1 * gelu_erf((float)sB * (hs * us1)) * vs1;
        e0 = e0n; e1 = e1n;
    }
#undef PEV
#undef PFU
#undef MBYTE
#undef DATA_R
#undef H_LOAD
}

__device__ __forceinline__ void peer_v(const Params& p, int t0, int ntok, int lane, int wid, float* outbase, size_t tmask, const float* lvec  ) {
    const int li = lane & 31; const bool hi = lane >= 32;
    const int lring = PEER_LVEC + wid * 16384;
    int lx16[4];
#pragma unroll
    for (int s4 = 0; s4 < 4; ++s4) lx16[s4] = (li ^ (2 * s4 + (hi ? 1 : 0))) * 16;
#define ISSUE_V(s, esel, ln) do { const int ea__ = __builtin_amdgcn_readlane(esel, (ln)), eb__ = __builtin_amdgcn_readlane(esel, (ln) + 1); const int ev_ = hi ? eb__ : ea__; \
        const unsigned char* gp_ = p.v_q + (size_t)ev_ * 512 + lx16[(s) & 3]; \
        __builtin_amdgcn_global_load_lds((const unsigned*)gp_, (__attribute__((address_space(3))) unsigned*)(smem + lring + (s) * 1024), 16, 0, 0); } while (0)
    const int trr = (lane & 15) >> 1, trc = lane & 1, trg = lane >> 4;
    const unsigned tr_base = (unsigned)(size_t)(lds_cptr)(smem + lring + (trr >> 1) * 1024 + (trr & 1) * 512 + ((trg ^ (trr & 3)) << 4) + trc * 8);
    const unsigned trE = tr_base + ((trr >> 2) ? 64u : 0u), trO = tr_base - ((trr >> 2) ? 64u : 0u);
#define TRB8(dst, va, OFF) asm volatile("ds_read_b64_tr_b8 %0, %1 offset:%2" : "=v"(dst) : "v"(va), "n"(OFF) : "memory")
    int e0 = p.eidx[(size_t)t0 * 128 + lane], e1 = p.eidx[(size_t)t0 * 128 + 64 + lane];
    float wA = p.gw[(size_t)t0 * 128 + lane], wB = p.gw[(size_t)t0 * 128 + 64 + lane];
#pragma unroll
    for (int s = 0; s < 16; ++s) ISSUE_V(s, e0, 2 * s);
    asm volatile("s_waitcnt vmcnt(0)" ::: "memory");
#pragma unroll 1
    for (int it = 0; it < ntok; ++it) {
        const int t = t0 + it;
        const int tn = (it + 1 < ntok) ? t + 1 : t;
        const int e0n = p.eidx[(size_t)tn * 128 + lane], e1n = p.eidx[(size_t)tn * 128 + 64 + lane];
        const float wAn = p.gw[(size_t)tn * 128 + lane], wBn = p.gw[(size_t)tn * 128 + 64 + lane];
        float wmax = fmaxf(fabsf(wA), fabsf(wB));
#pragma unroll
        for (int o = 32; o > 0; o >>= 1) wmax = fmaxf(wmax, __shfl_xor(wmax, o));
        const float Sw = fmaxf(wmax * (1.0f / 127.0f), 1e-30f), invS = 1.0f / Sw;
        const int wqa = (int)rintf(wA * invS), wqb = (int)rintf(wB * invS);
        const int wqsum = wave_isum(wqa + wqb);
        int WpA = (wqa & 0xff) << (8 * (lane & 3)), WpB = (wqb & 0xff) << (8 * (lane & 3));
        WpA |= __builtin_amdgcn_update_dpp(0, WpA, 0xB1, 0xf, 0xf, false); WpA |= __builtin_amdgcn_update_dpp(0, WpA, 0x4E, 0xf, 0xf, false);
        WpB |= __builtin_amdgcn_update_dpp(0, WpB, 0xB1, 0xf, 0xf, false); WpB |= __builtin_amdgcn_update_dpp(0, WpB, 0x4E, 0xf, 0xf, false);
        int acci[16];
#pragma unroll
        for (int i = 0; i < 16; ++i) acci[i] = 0;
#define VB_BATCH(b) do { \
            asm volatile("s_waitcnt vmcnt(12)" ::: "memory"); \
            const int wl_ = 8 * ((4 * Bq + (b)) & 7); \
            const int W0_ = __builtin_amdgcn_readlane(wsel_, wl_), W1_ = __builtin_amdgcn_readlane(wsel_, wl_ + 4); \
            u32x2 d_[8]; \
            TRB8(d_[0], trE, (b) * 4096 + 0);   TRB8(d_[1], trO, (b) * 4096 + 64);  TRB8(d_[2], trE, (b) * 4096 + 128); TRB8(d_[3], trO, (b) * 4096 + 192); \
            TRB8(d_[4], trE, (b) * 4096 + 256); TRB8(d_[5], trO, (b) * 4096 + 320); TRB8(d_[6], trE, (b) * 4096 + 384); TRB8(d_[7], trO, (b) * 4096 + 448); \
            asm volatile("s_waitcnt lgkmcnt(0)" : "+v"(d_[0]), "+v"(d_[1]), "+v"(d_[2]), "+v"(d_[3]), "+v"(d_[4]), "+v"(d_[5]), "+v"(d_[6]), "+v"(d_[7])); \
            _Pragma("unroll") for (int s_ = 0; s_ < 4; ++s_) ISSUE_V(4 * (b) + s_, vsel_, vln_ + 2 * (4 * (b) + s_));        \
            _Pragma("unroll") for (int i = 0; i < 8; ++i) { \
                const unsigned lo0 = d_[i].x & 0x0F0F0F0Fu, hi0 = (d_[i].x >> 4) & 0x0F0F0F0Fu, lo1 = d_[i].y & 0x0F0F0F0Fu, hi1 = (d_[i].y >> 4) & 0x0F0F0F0Fu; \
                acci[2 * i] = __builtin_amdgcn_sdot4((int)lo0, W0_, acci[2 * i], false); acci[2 * i] = __builtin_amdgcn_sdot4((int)lo1, W1_, acci[2 * i], false); \
                acci[2 * i + 1] = __builtin_amdgcn_sdot4((int)hi0, W0_, acci[2 * i + 1], false); acci[2 * i + 1] = __builtin_amdgcn_sdot4((int)hi1, W1_, acci[2 * i + 1], false); } \
            __builtin_amdgcn_sched_barrier(0); } while (0)
#pragma unroll 1
        for (int Bq = 0; Bq < 4; ++Bq) {
            int wsel_ = (Bq < 2) ? WpA : WpB; int vsel_ = (Bq == 0) ? e0 : ((Bq == 3) ? e0n : e1); asm volatile("" : "+v"(wsel_), "+v"(vsel_));
            const int vln_ = ((Bq + 1) & 1) * 32;
            VB_BATCH(0); VB_BATCH(1); VB_BATCH(2); VB_BATCH(3);
        }
#undef VB_BATCH
        float* outp = outbase + ((size_t)t & tmask) * D;
        const int c0 = 32 * (lane >> 4) + 2 * (lane & 15);
        typedef float f32x2 __attribute__((ext_vector_type(2)));
        unsigned xw[8];
#pragma unroll
        for (int i = 0; i < 8; ++i) xw[i] = *(const unsigned*)(p.x1 + (size_t)t * D + c0 + 128 * i);
        float y[16]; float s = 0.f;
#pragma unroll
        for (int i = 0; i < 8; ++i) {
            const f32x2 g2 = *(const f32x2*)(lvec + c0 + 128 * i);
            const float f0 = (float)(acci[2 * i] - 8 * wqsum) * Sw, f1 = (float)(acci[2 * i + 1] - 8 * wqsum) * Sw;
            const float v0 = ALPHA * bflo(xw[i]) + g2[0] * f0, v1 = ALPHA * bfhi(xw[i]) + g2[1] * f1;
            y[2 * i] = v0; y[2 * i + 1] = v1; s += v0 + v1;
        }
        const float mu = wave_sum(s) * (1.0f / D);
        float q = 0.f;
#pragma unroll
        for (int i = 0; i < 16; ++i) { y[i] -= mu; q += y[i] * y[i]; }
        const float rsd = rsqrtf(wave_sum(q) * (1.0f / D) + LN_EPS);
#pragma unroll
        for (int i = 0; i < 8; ++i) {
            const f32x2 gg = *(const f32x2*)(lvec + 1024 + c0 + 128 * i), bb = *(const f32x2*)(lvec + 2048 + c0 + 128 * i);
            f32x2 o; o[0] = y[2 * i] * rsd * gg[0] + bb[0]; o[1] = y[2 * i + 1] * rsd * gg[1] + bb[1];
            *(f32x2*)(outp + c0 + 128 * i) = o;
        }
        e0 = e0n; e1 = e1n; wA = wAn; wB = wBn;
    }
#undef ISSUE_V
#undef TRB8
}


#define XB_TMO      128
#define XB_XCNT(j)  (256  + 64 * (j))
#define XB_XSUB(j)  (1280 + 64 * (j))
#define XB_XGEN(j)  (2304 + 64 * (j))
#define XB_TOP      3328
#define XB_TOPGEN   3392
#define XCD_BAR_WORDS 3456
#define XB_SPIN_CAP (1u << 20)
#define LAS __attribute__((address_space(3)))
__device__ __forceinline__ unsigned xb_ld(unsigned* p)              { return __hip_atomic_load(p, __ATOMIC_RELAXED, __HIP_MEMORY_SCOPE_AGENT); }
__device__ __forceinline__ unsigned xb_add(unsigned* p, unsigned v) { return __hip_atomic_fetch_add(p, v, __ATOMIC_RELAXED, __HIP_MEMORY_SCOPE_AGENT); }
__device__ __forceinline__ unsigned xb_xcc_id() { return (unsigned)__builtin_amdgcn_s_getreg((3 << 11) | 20) & 0xFu; }
#define XB_SPIN(cond, bar) do { unsigned _sp = 0; while (cond) { __builtin_amdgcn_s_sleep(1); \
    if ((++_sp & 255u) == 0u) { if (xb_ld(&(bar)[XB_TMO])) break; if (_sp > XB_SPIN_CAP) { atomicAdd(&(bar)[XB_TMO], 1u); break; } } } } while (0)
struct XcdBarrier { unsigned* bar; unsigned x; volatile LAS unsigned* st; };
__device__ __forceinline__ XcdBarrier xcd_barrier_post(unsigned* bar, volatile LAS unsigned* st) {
    XcdBarrier b; b.bar = bar; b.x = xb_xcc_id(); b.st = st;
    if (threadIdx.x == 0) (void)xb_add(&bar[XB_XCNT(b.x)], 1u);
    return b;
}
__device__ __forceinline__ void xcd_barrier_complete(unsigned* bar, unsigned x, unsigned& nloc, unsigned& nx) {
    const unsigned G = gridDim.x * gridDim.y * gridDim.z;
    unsigned sum, cnt, mine, sp = 0u;
    for (;;) {
        sum = 0u; cnt = 0u; mine = 0u;
#pragma unroll
        for (unsigned j = 0; j < 16; ++j) { const unsigned c = xb_ld(&bar[XB_XCNT(j)]); sum += c; cnt += (c > 0u) ? 1u : 0u; mine = (j == x) ? c : mine; }
        if (sum == G) break;
        __builtin_amdgcn_s_sleep(1);
        if ((++sp & 255u) == 0u) { if (xb_ld(&bar[XB_TMO])) break; if (sp > XB_SPIN_CAP) { atomicAdd(&bar[XB_TMO], 1u); break; } }
    }
    nloc = mine > 0u ? mine : 1u; nx = cnt > 0u ? cnt : 1u;
}
__device__ __forceinline__ void xcd_barrier(const XcdBarrier& b) {
    asm volatile("s_waitcnt vmcnt(0)" ::: "memory");
    __syncthreads();
    if (threadIdx.x == 0) {
        unsigned* bar = b.bar;
        __builtin_amdgcn_s_waitcnt(0);
        unsigned nloc = b.st[0], nx = b.st[1];
        if (nloc == 0u) { xcd_barrier_complete(bar, b.x, nloc, nx); b.st[0] = nloc; b.st[1] = nx; }
        const unsigned old = xb_add(&bar[XB_XSUB(b.x)], 1u);
        const unsigned gen = old / nloc;
        if (old + 1u == (gen + 1u) * nloc) {
            __builtin_amdgcn_fence(__ATOMIC_RELEASE, "agent");
            asm volatile("s_waitcnt vmcnt(0)" ::: "memory");
            const unsigned og = xb_add(&bar[XB_TOP], 1u);
            const unsigned tg = og / nx;
            if (og + 1u == (tg + 1u) * nx) xb_add(&bar[XB_TOPGEN], 1u);
            else XB_SPIN(xb_ld(&bar[XB_TOPGEN]) == tg, bar);
            __builtin_amdgcn_fence(__ATOMIC_ACQUIRE, "agent");
            xb_add(&bar[XB_XGEN(b.x)], 1u);
            asm volatile("s_waitcnt vmcnt(0)" ::: "memory");
        } else {
            XB_SPIN(xb_ld(&bar[XB_XGEN(b.x)]) == gen, bar);
            __builtin_amdgcn_fence(__ATOMIC_ACQUIRE, "agent");
            asm volatile("s_waitcnt vmcnt(0)" ::: "memory");
        }
    }
    __syncthreads();
}

constexpr int MEGA_LDS0 = ATT_LDS > GEMM_LDS ? ATT_LDS : GEMM_LDS;
constexpr int MEGA_LDS = MEGA_LDS0 > PEER_LDS ? MEGA_LDS0 : PEER_LDS;
__global__ __launch_bounds__(256, 2) void mega_fwd(Params p) {
    cooperative_groups::grid_group grid = cooperative_groups::this_grid();
    asm volatile("s_nop 0\n\ts_nop 0\n\ts_nop 0\n\ts_nop 0\n\ts_nop 0\n\ts_nop 0\n\ts_nop 0\n\ts_nop 0\n\ts_nop 0\n\ts_nop 0\n\ts_nop 0\n\ts_nop 0\n\ts_nop 0\n\ts_nop 0");
    const int nblk = gridDim.x, bid = blockIdx.x;
    volatile LAS unsigned* xst = (volatile LAS unsigned*)(smem + MEGA_LDS);
    if (threadIdx.x == 0) { xst[0] = 0u; xst[1] = 0u; }
    __syncthreads();
    const XcdBarrier xb = xcd_barrier_post(p.bar, xst);
    for (int it = bid; it < PREP_MOD; it += nblk) mod_item(p, it);
    if (__builtin_expect(p.out == nullptr, 0)) grid.sync();
    xcd_barrier(xb);
    if ((bid >> 3) & 1) {
        for (int it = bid; it < PREP_REST; it += nblk) prep_item(p, it);
        for (int mt = bid; mt < T / 128; mt += nblk) modulate_rows(p.x, p.mod, SH1, SC1, p.hbuf, mt * 128, 128);
    } else {
        for (int mt = bid; mt < T / 128; mt += nblk) modulate_rows(p.x, p.mod, SH1, SC1, p.hbuf, mt * 128, 128);
        for (int it = bid; it < PREP_REST; it += nblk) prep_item(p, it);
    }
    xcd_barrier(xb);
    {
        const int x = bid & 7, rank = bid >> 3, per = nblk >> 3;
        EpiProj epi{p.proj};
        for (int mt = rank; mt < T / 128; mt += per) gemm_tile(p.hbuf, p.w_in_t, INW, mt * 128, x * 256, smem, epi);
        for (int mt = bid; mt < T / 128; mt += nblk) gemm_tile(p.hbuf, p.w_in_t, INW, mt * 128, 8 * 256, smem, epi);
    }
    xcd_barrier(xb);
    {
        const float lam = p.scal[0];
        const int xcd = bid & 7, rank = bid >> 3, per = nblk >> 3;
        for (int r0 = 0; r0 < ATT_ITEMS; r0 += nblk) { const int item = r0 + xcd * per + rank; if (item < ATT_ITEMS) attn_item(p, item, lam); }
    }
    xcd_barrier(xb);
    for (int mt = bid; mt < T / 128; mt += nblk) {
        { EpiY1 epi{p.x, p.mod, p.y1};
          for (int nt = 0; nt < D / 256; ++nt) gemm_tile(p.attn, p.w_out_t, D, mt * 128, nt * 256, smem, epi); }
        __syncthreads();
        ln1_rows(p, mt * 128);
        __syncthreads();
        for (int nt = 0; nt < 8; ++nt) { EpiTopk epi{p.hk, 2 * nt}; gemm_tile(p.hbuf, p.weff_t, 2048, mt * 128, nt * 256, smem, epi); }
        __syncthreads();
        route_combine(p, mt * 128);
        __syncthreads();
        const int ptid = opaque_tid(), lane = ptid & 63, wid = wave_of(ptid);
        peer_u(p, mt * 128 + wid * 32, 32, lane);
        __syncthreads();
    }
    xcd_barrier(xb);
    for (int mt = bid; mt < T / 128; mt += nblk) {
        const int ptid = opaque_tid(), lane = ptid & 63, wid = wave_of(ptid);
        {
            float* lv = (float*)smem; const int bb = (mt * 128) / S;
            *(f32x4*)(lv + ptid * 4) = *(const f32x4*)(p.mod + bb * MODW + G2 + ptid * 4);
            *(f32x4*)(lv + 1024 + ptid * 4) = *(const f32x4*)(p.ln2_g + ptid * 4);
            *(f32x4*)(lv + 2048 + ptid * 4) = *(const f32x4*)(p.ln2_b + ptid * 4);
            __syncthreads();
        }
        peer_v(p, mt * 128 + wid * 32, 32, lane, wid, p.out, ~(size_t)0, (const float*)smem);
        __syncthreads();
    }
}
}

extern "C" void kernel_launch(void* const* d_in, const int* in_sizes, int n_in, void* d_out, int out_size, void* d_ws, size_t ws_size, hipStream_t stream) {
    Params p{};
    p.x = (const float*)d_in[0]; p.c = (const float*)d_in[1]; p.w_ada = (const float*)d_in[2]; p.b_ada = (const float*)d_in[3];
    p.w_in = (const float*)d_in[4]; p.lq1 = (const float*)d_in[5]; p.lk1 = (const float*)d_in[6]; p.lq2 = (const float*)d_in[7]; p.lk2 = (const float*)d_in[8];
    p.subln_g = (const float*)d_in[9]; p.sinks = (const float*)d_in[10]; p.w_out = (const float*)d_in[11]; p.ln1_g = (const float*)d_in[12]; p.ln1_b = (const float*)d_in[13];
    p.w_pq = (const float*)d_in[14]; p.sub_keys = (const float*)d_in[15]; p.u_tab = (const float*)d_in[16]; p.v_tab = (const float*)d_in[17];
    p.ln2_g = (const float*)d_in[18]; p.ln2_b = (const float*)d_in[19];
    p.out = (float*)d_out;
    char* ws = (char*)d_ws; const size_t MiB = 1ull << 20;
    p.mod = (float*)(ws);
    p.bar = (unsigned*)(ws + 768 * 1024);
    p.scal = (float*)(ws + 768 * 1024 + 16384);
    p.w_in_t = (bf16_t*)(ws + 1 * MiB);
    p.w_out_t = (bf16_t*)(ws + 6 * MiB);
    p.weff_t = (bf16_t*)(ws + 8 * MiB);
    p.u_q = (unsigned char*)(ws + 12 * MiB);
    p.v_q = (unsigned char*)(ws + 28 * MiB);
    p.u_sc = (float*)(ws + 44 * MiB);
    p.v_sc = (float*)(ws + 44 * MiB + 65536);
    p.v_m = (unsigned char*)(ws + 45 * MiB);
    p.u_m = (unsigned char*)(ws + 46 * MiB);
    p.hbuf = (bf16_t*)(ws + 76 * MiB);
    p.proj = (bf16_t*)(ws + 204 * MiB);
    p.attn = (bf16_t*)(ws + 492 * MiB);
    p.x1 = p.attn;
    p.y1 = (bf16_t*)(ws + 332 * MiB);
    p.hq = (unsigned*)(ws + 620 * MiB);
    p.hsc = (float*)(ws + 684 * MiB);
    p.hk = (int*)(ws + 204 * MiB);
    p.eidx = (int*)(ws + 268 * MiB);
    p.gw = (float*)(ws + 300 * MiB);

    static int grid_blocks = 0;
    if (!grid_blocks) {
        int dev = 0, cus = 0, per_cu = 0;
        (void)hipGetDevice(&dev);
        (void)hipDeviceGetAttribute(&cus, hipDeviceAttributeMultiprocessorCount, dev);
        (void)hipFuncSetAttribute((const void*)mega_fwd, hipFuncAttributeMaxDynamicSharedMemorySize, MEGA_LDS + 16);
        (void)hipOccupancyMaxActiveBlocksPerMultiprocessor(&per_cu, mega_fwd, 256, MEGA_LDS + 16);
        if (per_cu > 2) per_cu = 2;
        grid_blocks = cus * per_cu;
        grid_blocks -= grid_blocks % 8;
    }
    (void)hipMemsetAsync(p.bar, 0, XCD_BAR_WORDS * sizeof(unsigned), stream);
    void* args[] = {&p};
    hipError_t e = hipLaunchCooperativeKernel((const void*)mega_fwd, dim3(grid_blocks), dim3(256), args, MEGA_LDS + 16, stream);
    if (e != hipSuccess) fprintf(stderr, "cooperative launch failed: %s (grid %d)\n", hipGetErrorString(e), grid_blocks);
}
```

```cpp
#include <hip/hip_runtime.h>
#include <hip/hip_cooperative_groups.h>
#include <stdint.h>
#include <cstdio>

namespace {
typedef unsigned short bf16_t;
typedef short bf16x8 __attribute__((ext_vector_type(8)));
typedef short s16x4 __attribute__((ext_vector_type(4)));
typedef float f32x4 __attribute__((ext_vector_type(4)));
typedef float f32x16 __attribute__((ext_vector_type(16)));
typedef unsigned u32x4 __attribute__((ext_vector_type(4)));
typedef unsigned u32x2 __attribute__((ext_vector_type(2)));
constexpr float LOG2E = 1.4426950408889634f;
constexpr float QSCALE = 0.125f * LOG2E;
typedef __bf16 bf16pair_t __attribute__((ext_vector_type(2)));
__device__ __forceinline__ unsigned cvtpk(float lo, float hi) { bf16pair_t v; v[0] = (__bf16)lo; v[1] = (__bf16)hi; return __builtin_bit_cast(unsigned, v); }
__device__ __forceinline__ int opaque_tid() { int t = threadIdx.x; asm volatile("" : "+v"(t)); return t; }
__device__ __forceinline__ int wave_of(int tid) { return __builtin_amdgcn_readfirstlane(tid >> 6); }
__device__ __forceinline__ float bf2f(bf16_t b) { return __uint_as_float((unsigned)b << 16); }
__device__ __forceinline__ float bflo(unsigned w) { return __uint_as_float(w << 16); }
__device__ __forceinline__ float bfhi(unsigned w) { return __uint_as_float(w & 0xffff0000u); }

constexpr int D = 1024, NB = 32, S = 2048, T = NB * S;
constexpr int INW = 2304, MODW = 6144;
constexpr float LN_EPS = 1e-5f;
constexpr float ALPHA = 1.189207115002721f;
constexpr float LAMBDA_INIT = 0.2f;
constexpr int SH1 = 0, SC1 = 1024, G1 = 2048, SH2 = 3072, SC2 = 4096, G2 = 5120;
__device__ __forceinline__ size_t tm_act(int r, int k) { return (size_t)(r >> 7) * 131072 + (size_t)((k >> 5) * 4096 + (r & 127) * 32 + (k & 31)); }
__device__ __forceinline__ size_t tm_w(int n, int k, int N) { return ((size_t)(k >> 5) * N + n) * 32 + (k & 31); }


struct Params {
    const float *x, *c, *w_ada, *b_ada, *w_in, *lq1, *lk1, *lq2, *lk2, *subln_g, *sinks, *w_out, *ln1_g, *ln1_b, *w_pq, *sub_keys, *u_tab, *v_tab, *ln2_g, *ln2_b;
    float* out;
    float* mod;
    bf16_t* w_in_t;
    bf16_t* w_out_t;
    bf16_t* weff_t;
    unsigned char* u_q;
    unsigned char* v_q;
    float* u_sc;
    unsigned char* u_m;
    unsigned char* v_m;
    float* v_sc;
    bf16_t* hbuf;
    bf16_t* proj;
    bf16_t* attn;
    bf16_t* y1;
    unsigned* hq;
    float* hsc;
    bf16_t* x1;
    int* hk;
    int* eidx;
    float* gw;
    unsigned* bar;
    float* scal;
};

extern __shared__ __attribute__((aligned(16))) char smem[];

constexpr int PREP_MOD = 384;
constexpr int PREP_TIN = 16 * 36;
constexpr int PREP_TOUT = 16 * 16;
constexpr int PREP_WEFF = 16 * 2 * 32;
constexpr int PREP_CVT = 512;
constexpr int PREP_REST = PREP_TIN + PREP_TOUT + PREP_WEFF + 2 * PREP_CVT;

__device__ __forceinline__ void tr_tile(const float* __restrict__ src, int N, int K, bf16_t* __restrict__ dst, int kt, int nt, float* lds) {
    const int tid = opaque_tid();
#pragma unroll
    for (int i = 0; i < 16; ++i) { const int idx = tid + i * 256, r = idx >> 6, cc = idx & 63; lds[r * 65 + cc] = src[(size_t)(kt * 64 + r) * N + nt * 64 + cc]; }
    __syncthreads();
#pragma unroll
    for (int i = 0; i < 16; ++i) { const int idx = tid + i * 256, n = idx >> 6, k = idx & 63; dst[tm_w(nt * 64 + n, kt * 64 + k, N)] = (bf16_t)(cvtpk(lds[k * 65 + n], 0.f) & 0xffffu); }
    __syncthreads();
}

__device__ __forceinline__ void mod_item(const Params& p, int item) {
    const int tid = opaque_tid(), lane = tid & 63, wid = wave_of(tid);
    float* lds = (float*)smem;
    const int cb = item >> 2, bg = item & 3, j = cb * 64 + lane;
    for (int i = tid; i < 8192; i += 256) { const int b = i >> 10, k = i & 1023; const float v = p.c[(bg * 8 + b) * D + k]; lds[k * 8 + b] = v / (1.0f + expf(-v)); }
    __syncthreads();
    float acc[8];
#pragma unroll
    for (int b = 0; b < 8; ++b) acc[b] = 0.f;
    const float* wp = p.w_ada + (size_t)(wid * 256) * MODW + j;
#pragma unroll 4
    for (int k = 0; k < 256; ++k) {
        const float wv = wp[(size_t)k * MODW];
        const f32x4 s0 = *(const f32x4*)(lds + (wid * 256 + k) * 8), s1 = *(const f32x4*)(lds + (wid * 256 + k) * 8 + 4);
        acc[0] += s0[0] * wv; acc[1] += s0[1] * wv; acc[2] += s0[2] * wv; acc[3] += s0[3] * wv;
        acc[4] += s1[0] * wv; acc[5] += s1[1] * wv; acc[6] += s1[2] * wv; acc[7] += s1[3] * wv;
    }
    float* red = lds + 8192;
#pragma unroll
    for (int b = 0; b < 8; ++b) red[(wid * 8 + b) * 64 + lane] = acc[b];
    __syncthreads();
#pragma unroll
    for (int r = 0; r < 2; ++r) {
        const int o = tid + 256 * r, b = o >> 6, col = o & 63;
        const float s = (red[(0 * 8 + b) * 64 + col] + red[(1 * 8 + b) * 64 + col]) + (red[(2 * 8 + b) * 64 + col] + red[(3 * 8 + b) * 64 + col]);
        p.mod[(bg * 8 + b) * MODW + cb * 64 + col] = s + p.b_ada[cb * 64 + col];
    }
    if (item == 0 && tid == 0) {
        float s1 = 0.f, s2 = 0.f;
        for (int i = 0; i < 64; ++i) { s1 += p.lq1[i] * p.lk1[i]; s2 += p.lq2[i] * p.lk2[i]; }
        p.scal[0] = expf(s1) - expf(s2) + LAMBDA_INIT;
    }
    __syncthreads();
}

__device__ __forceinline__ void prep_item(const Params& p, int item) {
    const int tid = opaque_tid();
    float* lds = (float*)smem;
    if (item < PREP_TIN) { tr_tile(p.w_in, INW, D, p.w_in_t, item / 36, item % 36, lds); return; }
    item -= PREP_TIN;
    if (item < PREP_TOUT) { tr_tile(p.w_out, D, D, p.w_out_t, item / 16, item % 16, lds); return; }
    item -= PREP_TOUT;
    if (item < PREP_WEFF) {
        const int hp = item >> 6, nh = (item >> 5) & 1, ct = item & 31;
        float* ks = lds;
        float* wsm = lds + 64 * 129;
        for (int i = tid; i < 64 * 128; i += 256) { const int n = i >> 7, d = i & 127; ks[n * 129 + d] = p.sub_keys[((size_t)hp * 128 + nh * 64 + n) * 128 + d]; }
        for (int i = tid; i < 32 * 128; i += 256) { const int cc = i >> 7, d = i & 127; wsm[cc * 128 + d] = p.w_pq[(size_t)(ct * 32 + cc) * 2048 + hp * 128 + d]; }
        __syncthreads();
        const int n = tid & 63, cb = (tid >> 6) * 8;
        float acc[8];
#pragma unroll
        for (int cc = 0; cc < 8; ++cc) acc[cc] = 0.f;
        for (int d = 0; d < 128; ++d) { const float kv = ks[n * 129 + d];
#pragma unroll
            for (int cc = 0; cc < 8; ++cc) acc[cc] += kv * wsm[(cb + cc) * 128 + d]; }
        u32x4 w; w.x = cvtpk(acc[0], acc[1]); w.y = cvtpk(acc[2], acc[3]); w.z = cvtpk(acc[4], acc[5]); w.w = cvtpk(acc[6], acc[7]);
        *(u32x4*)(p.weff_t + tm_w(hp * 128 + nh * 64 + n, ct * 32 + cb, 2048)) = w;
        __syncthreads();
        return;
    }
    item -= PREP_WEFF;
    {
        const bool isv = item >= PREP_CVT;
        const float* src = isv ? p.v_tab : p.u_tab; unsigned char* dst = isv ? p.v_q : p.u_q; unsigned char* mdst = isv ? p.v_m : p.u_m; float* scl = isv ? p.v_sc : p.u_sc;
        const int lane = tid & 63, wid = wave_of(tid);
        for (int i0 = 0; i0 < 8; i0 += 4) {
            f32x4 vv[4][4];
#pragma unroll
            for (int r = 0; r < 4; ++r) { const float* rp = src + (size_t)((item % PREP_CVT) * 32 + wid * 8 + i0 + r) * D + lane * 16;
#pragma unroll
                for (int j = 0; j < 4; ++j) vv[r][j] = *(const f32x4*)(rp + 4 * j); }
#pragma unroll
            for (int r = 0; r < 4; ++r) {
                const int e = (item % PREP_CVT) * 32 + wid * 8 + i0 + r;
                float gm = 0.f;
#pragma unroll
                for (int j = 0; j < 4; ++j) gm = fmaxf(gm, fmaxf(fmaxf(fabsf(vv[r][j][0]), fabsf(vv[r][j][1])), fmaxf(fabsf(vv[r][j][2]), fabsf(vv[r][j][3]))));
                float am = gm;
#pragma unroll
                for (int o = 32; o > 0; o >>= 1) am = fmaxf(am, __shfl_xor(am, o));
                am = fmaxf(am, 1e-30f);
                gm = fmaxf(gm, __shfl_xor(gm, 1));
                int mq = (int)ceilf(gm * 255.0f / am); mq = mq < 1 ? 1 : (mq > 255 ? 255 : mq); if (isv) mq = 255;
                const float gi = 7.0f * 255.0f / (am * (float)mq);
                unsigned w0 = 0u, w1 = 0u;
#pragma unroll
                for (int j = 0; j < 4; ++j)
#pragma unroll
                    for (int q = 0; q < 4; ++q) {
                        int n = (int)rintf(vv[r][j][q] * gi); n = n < -7 ? -7 : (n > 7 ? 7 : n); n = isv ? n + 8 : (n & 15);
                        const int idx = 4 * j + q;
                        if (idx < 8) w0 |= (unsigned)n << (4 * idx); else w1 |= (unsigned)n << (4 * (idx - 8));
                    }
                u32x2 ww; ww.x = w0; ww.y = w1;
                *(u32x2*)(dst + (size_t)e * 512 + lane * 8) = ww;
                if ((lane & 1) == 0) mdst[(size_t)e * 32 + (lane >> 1)] = (unsigned char)mq;
                if (lane == 0) scl[e] = am * (1.0f / (255.0f * 7.0f));
            }
        }
    }
}

__device__ __forceinline__ void modulate_rows(const float* __restrict__ x, const float* __restrict__ mod, int sh_off, int sc_off, bf16_t* __restrict__ h, int r0, int nrows) {
    const int tid = opaque_tid();
    for (int i = tid; i < nrows * 128; i += 256) {
        const int r = r0 + (i >> 7), k = (i & 127) * 8, b = r / S;
        const float* xp = x + (size_t)r * D + k; const float* sc = mod + b * MODW + sc_off + k; const float* sh = mod + b * MODW + sh_off + k;
        const float4 x0 = *(const float4*)xp, x1v = *(const float4*)(xp + 4), c0 = *(const float4*)sc, c1 = *(const float4*)(sc + 4), s0 = *(const float4*)sh, s1 = *(const float4*)(sh + 4);
        u32x4 w;
        w.x = cvtpk(x0.x * (1.f + c0.x) + s0.x, x0.y * (1.f + c0.y) + s0.y); w.y = cvtpk(x0.z * (1.f + c0.z) + s0.z, x0.w * (1.f + c0.w) + s0.w);
        w.z = cvtpk(x1v.x * (1.f + c1.x) + s1.x, x1v.y * (1.f + c1.y) + s1.y); w.w = cvtpk(x1v.z * (1.f + c1.z) + s1.z, x1v.w * (1.f + c1.w) + s1.w);
        *(u32x4*)(h + tm_act(r, k)) = w;
    }
}

constexpr int GEMM_STAGE = 24576;
constexpr int GEMM_LDS = 3 * GEMM_STAGE;
constexpr int GK = 1024;
#define GLDS16(gp, off) __builtin_amdgcn_global_load_lds((const unsigned*)(gp), (__attribute__((address_space(3))) unsigned*)(smem + (off)), 16, 0, 0)
template <class Epi>
__device__ __forceinline__ void gemm_tile(const bf16_t* __restrict__ A, const bf16_t* __restrict__ Bt, int BN, int m0, int n0, char* lds, Epi& epi) {
    const int tid = opaque_tid(), lane = tid & 63, wid = wave_of(tid), wm = wid >> 1, wn = wid & 1;
    const int swz = (((lane & 3) ^ ((0 - (lane >> 4)) & 3)) * 8), r16 = lane >> 2;
    const int goff = r16 * 32 + swz;
    const int goffB = Epi::PERM ? (8 * (r16 >> 2) + (r16 & 3)) * 32 + swz : goff;
    constexpr int BQ1 = Epi::PERM ? 4 * 32 : 16 * 32, BQ2 = 32 * 32, BQ3 = Epi::PERM ? 36 * 32 : 48 * 32;
    const bf16_t* Ab = A + (size_t)m0 * GK + wid * 1024 + goff; const bf16_t* Bb = Bt + (size_t)(n0 + wid * 64) * 32 + goffB;
    const int bks = BN * 32;
    const int dstA = wid * 2048, dstB = 8192 + wid * 4096;
    const int fsw = (((lane >> 4) ^ (0 - ((lane & 15) >> 2))) & 3) * 16;
    const int fa = (wm * 64 + (lane & 15)) * 64 + fsw, fb = 8192 + (wn * 128 + (lane & 15)) * 64 + fsw;
    f32x4 acc[4][8];
#pragma unroll
    for (int i = 0; i < 4; ++i)
#pragma unroll
        for (int j = 0; j < 8; ++j) acc[i][j] = (f32x4){0.f, 0.f, 0.f, 0.f};
    constexpr int nk = GK / 32;
#define GEMM_STAGE_LOAD(kt, st) do { const int so_ = (st) * GEMM_STAGE; \
        GLDS16(Ab + (kt) * 4096, so_ + dstA); GLDS16(Ab + (kt) * 4096 + 512, so_ + dstA + 1024); const bf16_t* bq_ = Bb + (size_t)(kt) * bks; \
        GLDS16(bq_, so_ + dstB); GLDS16(bq_ + BQ1, so_ + dstB + 1024); GLDS16(bq_ + BQ2, so_ + dstB + 2048); GLDS16(bq_ + BQ3, so_ + dstB + 3072); } while (0)
    GEMM_STAGE_LOAD(0, 0);
    GEMM_STAGE_LOAD(1, 1);
    int cur = 0, nx2 = 2 * GEMM_STAGE;
#pragma unroll 1
    for (int kt = 0; kt < nk; ++kt) {
        if (kt + 1 < nk) asm volatile("s_waitcnt vmcnt(6)" ::: "memory"); else asm volatile("s_waitcnt vmcnt(0)" ::: "memory");
        __builtin_amdgcn_s_barrier();
        asm volatile("" ::: "memory");
        bf16x8 af[4], bfr[8];
#pragma unroll
        for (int i = 0; i < 4; ++i) af[i] = *(const bf16x8*)(lds + cur + fa + i * 1024);
#pragma unroll
        for (int j = 0; j < 8; ++j) bfr[j] = *(const bf16x8*)(lds + cur + fb + j * 1024);
        __builtin_amdgcn_sched_barrier(0);
        if (kt + 2 < nk) { const int so_ = nx2;
            GLDS16(Ab + (kt + 2) * 4096, so_ + dstA); GLDS16(Ab + (kt + 2) * 4096 + 512, so_ + dstA + 1024); const bf16_t* bq_ = Bb + (size_t)(kt + 2) * bks;
            GLDS16(bq_, so_ + dstB); GLDS16(bq_ + BQ1, so_ + dstB + 1024); GLDS16(bq_ + BQ2, so_ + dstB + 2048); GLDS16(bq_ + BQ3, so_ + dstB + 3072); }
        __builtin_amdgcn_sched_barrier(0);
#pragma unroll
        for (int j = 0; j < 8; ++j)
#pragma unroll
            for (int i = 0; i < 4; ++i) acc[i][j] = __builtin_amdgcn_mfma_f32_16x16x32_bf16(bfr[j], af[i], acc[i][j], 0, 0, 0);
        nx2 = cur; cur = (cur == 2 * GEMM_STAGE) ? 0 : cur + GEMM_STAGE;
    }
    __syncthreads();
#undef GEMM_STAGE_LOAD
    epi(acc, m0 + wm * 64, n0 + wn * 128, lane, lds);
}

struct EpiProj {
    static constexpr bool PERM = true;
    bf16_t* out;
    __device__ __forceinline__ void operator()(f32x4 (&acc)[4][8], int mb, int nb, int lane, char*) {
#pragma unroll
        for (int g = 0; g < 4; ++g) {
            const int col = nb + g * 32 + (lane >> 4) * 8;
            const float sc = (col < 512 || (col >= 1536 && col < 2048)) ? QSCALE : 1.0f;
#pragma unroll
            for (int i = 0; i < 4; ++i) {
                const int row = mb + i * 16 + (lane & 15);
                const f32x4 a = acc[i][2 * g], c = acc[i][2 * g + 1];
                u32x4 w; w.x = cvtpk(a[0] * sc, a[1] * sc); w.y = cvtpk(a[2] * sc, a[3] * sc); w.z = cvtpk(c[0] * sc, c[1] * sc); w.w = cvtpk(c[2] * sc, c[3] * sc);
                *(u32x4*)(out + (size_t)row * INW + col) = w;
            }
        }
    }
};


constexpr int ATT_WS = 69632;
constexpr int ATT_LDS = ATT_WS + 4 * 256;
#define MFMA32(a, b, c) __builtin_amdgcn_mfma_f32_32x32x16_bf16(a, b, c, 0, 0, 0)
typedef short v4i16_t __attribute__((ext_vector_type(4)));
typedef __attribute__((address_space(3))) const char* lds_cptr;
__device__ __forceinline__ s16x4 vtr(const char* p) { return __builtin_bit_cast(s16x4, __builtin_amdgcn_ds_read_tr16_b64_v4i16((__attribute__((address_space(3))) v4i16_t*)(lds_cptr)p)); }
__device__ __forceinline__ int crow(int r, int hi) { return (r & 3) + 8 * (r >> 2) + 4 * hi; }
__device__ __forceinline__ float max3f(float a, float b, float c) { float r; asm("v_max3_f32 %0, %1, %2, %3" : "=v"(r) : "v"(a), "v"(b), "v"(c)); return r; }
__device__ __forceinline__ float rowmax32(const f32x16& p0, const f32x16& p1) {
    float x0 = p0[0], x1 = p1[0]; asm volatile("s_nop 7\n\ts_nop 3" : "+v"(x0), "+v"(x1));
    float a = max3f(x0, p0[1], p0[2]), b = max3f(x1, p1[1], p1[2]);
#pragma unroll
    for (int r = 3; r < 15; r += 2) { a = max3f(a, p0[r], p0[r + 1]); b = max3f(b, p1[r], p1[r + 1]); }
    a = max3f(a, p0[15], b); a = fmaxf(a, p1[15]);
    auto rr = __builtin_amdgcn_permlane32_swap(__float_as_uint(a), __float_as_uint(a), false, false);
    return fmaxf(__uint_as_float(rr[0]), __uint_as_float(rr[1]));
}

struct VFrag { u32x2 lo, hh; };
#define VTR1(dst, va, OFF) asm volatile("ds_read_b64_tr_b16 %0, %1 offset:%2" : "=v"(dst) : "v"(va), "n"(OFF) : "memory")
template <int DV, int KS>
__device__ __forceinline__ void vload(VFrag (&f)[DV / 32], unsigned va) {
    constexpr int KBS = (DV / 32) * 512;
    VTR1(f[0].lo, va, (2 * KS) * KBS); VTR1(f[0].hh, va, (2 * KS + 1) * KBS);
    VTR1(f[1].lo, va, (2 * KS) * KBS + 512); VTR1(f[1].hh, va, (2 * KS + 1) * KBS + 512);
    if constexpr (DV == 128) {
        VTR1(f[2].lo, va, (2 * KS) * KBS + 1024); VTR1(f[2].hh, va, (2 * KS + 1) * KBS + 1024);
        VTR1(f[3].lo, va, (2 * KS) * KBS + 1536); VTR1(f[3].hh, va, (2 * KS + 1) * KBS + 1536);
    }
}
template <int DV, int N>
__device__ __forceinline__ void vwait(VFrag (&f)[DV / 32]) {
    if constexpr (DV == 128) asm volatile("s_waitcnt lgkmcnt(%8)" : "+v"(f[0].lo), "+v"(f[0].hh), "+v"(f[1].lo), "+v"(f[1].hh), "+v"(f[2].lo), "+v"(f[2].hh), "+v"(f[3].lo), "+v"(f[3].hh) : "n"(N));
    else asm volatile("s_waitcnt lgkmcnt(%4)" : "+v"(f[0].lo), "+v"(f[0].hh), "+v"(f[1].lo), "+v"(f[1].hh) : "n"(N));
}
template <int DV, int KS>
__device__ __forceinline__ void pv_step(VFrag (&cur)[DV / 32], VFrag (&nxt)[DV / 32], unsigned va, const u32x4& pw, f32x16 (&o)[DV / 32]) {
    if constexpr (KS < 3) { vload<DV, KS + 1>(nxt, va); vwait<DV, 2 * (DV / 32)>(cur); } else vwait<DV, 0>(cur);
    const bf16x8 pa = __builtin_bit_cast(bf16x8, pw);
#pragma unroll
    for (int db = 0; db < DV / 32; ++db) {
        const u32x4 w = (u32x4){cur[db].lo.x, cur[db].lo.y, cur[db].hh.x, cur[db].hh.y};
        o[db] = MFMA32(pa, __builtin_bit_cast(bf16x8, w), o[db]);
    }
}
template <int DV, int MODE>
__device__ __forceinline__ void attn_tile(const char* kimg, const char* vimg, const bf16x8 (&qr)[4], f32x16 (&o)[DV / 32], float& m, float& l, int k0, int qpos, float slope2,
                                          bool need_mask, float* wsf, int r32, int hi, int lane) {
    const char* kp = kimg + r32 * 128; const int kx = (r32 >> 1) & 7;
    const unsigned va = (unsigned)(size_t)(lds_cptr)(vimg + ((lane >> 4) & 1) * 32 + (lane & 3) * 8 + (4 * hi + ((lane & 15) >> 2)) * 64);
    VFrag va0[DV / 32], va1[DV / 32];
    vload<DV, 0>(va0, va);
    const float base0 = slope2 * (float)(k0 + 4 * hi - qpos) - m;
    f32x16 c0, c1;
#pragma unroll
    for (int r = 0; r < 16; ++r) { const float cst = (float)((r & 3) + 8 * (r >> 2)); c0[r] = fmaf(slope2, cst, base0); c1[r] = fmaf(slope2, cst + 32.0f, base0); }
    bf16x8 kf[8];
#pragma unroll
    for (int d0 = 0; d0 < 4; ++d0) { const int po = ((2 * d0 + hi) ^ kx) * 16; kf[2 * d0] = *(const bf16x8*)(kp + po); kf[2 * d0 + 1] = *(const bf16x8*)(kp + 4096 + po); }
    __builtin_amdgcn_sched_barrier(0);
#pragma unroll
    for (int d0 = 0; d0 < 4; ++d0) { c0 = MFMA32(kf[2 * d0], qr[d0], c0); c1 = MFMA32(kf[2 * d0 + 1], qr[d0], c1); }
    if (need_mask) {
        const int kb = k0 + 4 * hi;
#pragma unroll
        for (int r = 0; r < 16; ++r) {
            const int key = kb + (r & 3) + 8 * (r >> 2);
            bool v0 = key <= qpos, v1 = key + 32 <= qpos;
            if (MODE == 1) { v0 = v0 && (key > qpos - 128); v1 = v1 && (key + 32 > qpos - 128); }
            c0[r] = v0 ? c0[r] : -INFINITY; c1[r] = v1 ? c1[r] : -INFINITY;
        }
    }
    const float rm = rowmax32(c0, c1);
    if (__any(rm > 8.0f)) {
        const float delta = fmaxf(rm, 0.f); m += delta; const float alpha = exp2f(-delta); l *= alpha;
#pragma unroll
        for (int r = 0; r < 16; ++r) { c0[r] -= delta; c1[r] -= delta; }
        if (hi == 0) wsf[r32] = alpha;
        __builtin_amdgcn_s_waitcnt(0xc07f);
        int q4 = 4 * hi; asm volatile("" : "+v"(q4));
        const float* wb = wsf + q4;
#pragma unroll
        for (int r = 0; r < 16; ++r) { const float a = wb[(r & 3) + 8 * (r >> 2)];
#pragma unroll
            for (int db = 0; db < DV / 32; ++db) o[db][r] *= a; }
    }
#pragma unroll
    for (int r = 0; r < 16; ++r) { c0[r] = __builtin_amdgcn_exp2f(c0[r]); c1[r] = __builtin_amdgcn_exp2f(c1[r]); }
    {
        typedef float f32x2 __attribute__((ext_vector_type(2)));
        f32x2 t[8];
#pragma unroll
        for (int r = 0; r < 8; ++r) t[r] = (f32x2){c0[2 * r], c0[2 * r + 1]} + (f32x2){c1[2 * r], c1[2 * r + 1]};
#pragma unroll
        for (int r = 0; r < 4; ++r) t[r] = t[r] + t[r + 4];
        t[0] = (t[0] + t[2]) + (t[1] + t[3]);
        l += t[0].x + t[0].y;
    }
    u32x4 pw[4];
#pragma unroll
    for (int s = 0; s < 2; ++s) {
        pw[s] = (u32x4){cvtpk(c0[8 * s], c0[8 * s + 1]), cvtpk(c0[8 * s + 2], c0[8 * s + 3]), cvtpk(c0[8 * s + 4], c0[8 * s + 5]), cvtpk(c0[8 * s + 6], c0[8 * s + 7])};
        pw[2 + s] = (u32x4){cvtpk(c1[8 * s], c1[8 * s + 1]), cvtpk(c1[8 * s + 2], c1[8 * s + 3]), cvtpk(c1[8 * s + 4], c1[8 * s + 5]), cvtpk(c1[8 * s + 6], c1[8 * s + 7])};
    }
    pv_step<DV, 0>(va0, va1, va, pw[0], o);
    pv_step<DV, 1>(va1, va0, va, pw[1], o);
    pv_step<DV, 2>(va0, va1, va, pw[2], o);
    pv_step<DV, 3>(va1, va0, va, pw[3], o);
}

template <int DV>
__device__ __forceinline__ void attn_finish(f32x16 (&o)[DV / 32], float l, float extra, float* wsf, float* ost, int r32, int hi) {
    auto rr = __builtin_amdgcn_permlane32_swap(__float_as_uint(l), __float_as_uint(l), false, false);
    const float lt = __uint_as_float(rr[0]) + __uint_as_float(rr[1]) + extra;
    if (hi == 0) wsf[32 + r32] = 1.0f / lt;
    __builtin_amdgcn_s_waitcnt(0xc07f);
    int q4 = 4 * hi; asm volatile("" : "+v"(q4));
    const float* wb = wsf + 32 + q4; float* ob = ost + q4 * (DV + 4) + r32;
#pragma unroll
    for (int r = 0; r < 16; ++r) { const int qc = (r & 3) + 8 * (r >> 2); const float a = wb[qc];
#pragma unroll
        for (int db = 0; db < DV / 32; ++db) ob[qc * (DV + 4) + db * 32] = o[db][r] * a; }
}

__device__ __forceinline__ void diff_unit(const Params& p, int b, int h, int qblk, float lam) {
    const int tid = opaque_tid(), lane = tid & 63, wid = wave_of(tid), r32 = lane & 31, hi = lane >> 5, map = wid >> 1, chunk = wid & 1;
    const bf16_t* base = p.proj + (size_t)b * S * INW;
    const int q0 = qblk * 64 + chunk * 32, qpos = q0 + r32;
    const float slope2 = exp2f(-8.0f * (float)(9 + h) / 12.0f) * LOG2E;
    float* wsf = (float*)(smem + ATT_WS) + wid * 64;
    bf16x8 qr[4];
    { const bf16_t* qp = base + (size_t)qpos * INW + h * 128 + map * 64 + hi * 8;
#pragma unroll
      for (int d0 = 0; d0 < 4; ++d0) qr[d0] = *(const bf16x8*)(qp + d0 * 16); }
    f32x16 o[4];
#pragma unroll
    for (int db = 0; db < 4; ++db) o[db] = f32x16{};
    float m = 0.f, l = 0.f;
    const int kc0 = ((lane & 7) ^ (lane >> 4)) * 8;
    const bf16_t* kg = base + (size_t)(32 * (wid & 1) + (lane >> 3)) * INW + 512 + h * 128 + (wid >> 1) * 64;
    const bf16_t* vg = base + (size_t)(32 * (wid & 1) + ((lane >> 2) & 7)) * INW + 1024 + h * 128 + (wid >> 1) * 64 + (lane >> 5) * 32 + (lane & 3) * 8;
    const int kdst = (wid >> 1) * 8192 + (wid & 1) * 4096, vdst = 16384 + (wid & 1) * 8192 + (wid >> 1) * 1024;
    const int nt = qblk + 1;
#define GLDS(gp, off) __builtin_amdgcn_global_load_lds((const unsigned*)(gp), (__attribute__((address_space(3))) unsigned*)(smem + (off)), 16, 0, 0)
#define DIFF_STAGE(t, st) do { const size_t go = (size_t)(t) * 64 * INW; const int sb_ = (st) * 32768; \
        GLDS(kg + go + kc0, sb_ + kdst); GLDS(kg + go + (size_t)8 * INW + (kc0 ^ 32), sb_ + kdst + 1024); \
        GLDS(kg + go + (size_t)16 * INW + kc0, sb_ + kdst + 2048); GLDS(kg + go + (size_t)24 * INW + (kc0 ^ 32), sb_ + kdst + 3072); \
        _Pragma("unroll") for (int kb = 0; kb < 4; ++kb) GLDS(vg + go + (size_t)kb * 8 * INW, sb_ + vdst + kb * 2048); } while (0)
    DIFF_STAGE(0, 0);
    __syncthreads();
        asm volatile(".p2align 6\n\ts_nop 0\n\ts_nop 0\n\ts_nop 0\n\ts_nop 0\n\ts_nop 0\n\ts_nop 0\n\ts_nop 0\n\ts_nop 0\n\ts_nop 0\n\ts_nop 0\n\ts_nop 0\n\ts_nop 0\n\ts_nop 0\n\ts_nop 0\n\ts_nop 0");
    for (int t = 0; t < nt; ++t) {
        if (t + 1 < nt) DIFF_STAGE(t + 1, (t + 1) & 1);
        const char* sb = smem + (t & 1) * 32768;
        attn_tile<128, 0>(sb + map * 8192, sb + 16384, qr, o, m, l, t * 64, qpos, slope2, t * 64 + 63 > q0, wsf, r32, hi, lane);
        __syncthreads();
    }
#undef DIFF_STAGE
    float* ost = (float*)smem + wid * (32 * 132);
    attn_finish<128>(o, l, 0.f, wsf, ost, r32, hi);
    __syncthreads();
    {
        int tq = tid; asm volatile("" : "+v"(tq));
        const int q = tq >> 2, dq = tq & 3, ch = q >> 5, qi = q & 31;
        const float* o1 = (const float*)smem + ch * (32 * 132) + qi * 132 + dq * 32;
        const float* o2 = (const float*)smem + (2 + ch) * (32 * 132) + qi * 132 + dq * 32;
        float v[32]; float ss = 0.f;
#pragma unroll
        for (int i = 0; i < 8; ++i) { const f32x4 a = *(const f32x4*)(o1 + 4 * i), c = *(const f32x4*)(o2 + 4 * i);
#pragma unroll
            for (int e = 0; e < 4; ++e) { const float x = a[e] - lam * c[e]; v[4 * i + e] = x; ss += x * x; } }
        ss += __shfl_xor(ss, 1); ss += __shfl_xor(ss, 2);
        const float rn = rsqrtf(ss * (1.0f / 128.0f) + LN_EPS) * (1.0f - LAMBDA_INIT);
        const float* g = p.subln_g + dq * 32;
        bf16_t* op = p.attn + tm_act(b * S + qblk * 64 + q, h * 128 + dq * 32);
#pragma unroll
        for (int i = 0; i < 4; ++i) { u32x4 w;
            w.x = cvtpk(v[8 * i] * rn * g[8 * i], v[8 * i + 1] * rn * g[8 * i + 1]); w.y = cvtpk(v[8 * i + 2] * rn * g[8 * i + 2], v[8 * i + 3] * rn * g[8 * i + 3]);
            w.z = cvtpk(v[8 * i + 4] * rn * g[8 * i + 4], v[8 * i + 5] * rn * g[8 * i + 5]); w.w = cvtpk(v[8 * i + 6] * rn * g[8 * i + 6], v[8 * i + 7] * rn * g[8 * i + 7]);
            *(u32x4*)(op + 8 * i) = w; }
    }
    __syncthreads();
}

__device__ __forceinline__ void swa_unit(const Params& p, int b, int kv, int qc) {
    const int tid = opaque_tid(), lane = tid & 63, wid = wave_of(tid), r32 = lane & 31, hi = lane >> 5, hq = kv * 4 + wid;
    const bf16_t* base = p.proj + (size_t)b * S * INW;
    const int q0 = qc * 32, qpos = q0 + r32;
    const float slope2 = exp2f(-8.0f * (float)(1 + hq) / 12.0f) * LOG2E;
    float* wsf = (float*)(smem + ATT_WS) + wid * 64;
    bf16x8 qr[4];
    { const bf16_t* qp = base + (size_t)qpos * INW + 1536 + hq * 64 + hi * 8;
#pragma unroll
      for (int d0 = 0; d0 < 4; ++d0) qr[d0] = *(const bf16x8*)(qp + d0 * 16); }
    f32x16 o[2]; o[0] = f32x16{}; o[1] = f32x16{};
    float m = 0.f, l = 0.f;
    const int kc0 = ((lane & 7) ^ (lane >> 4)) * 8;
    const bf16_t* kg = base + (size_t)(16 * wid + (lane >> 3)) * INW + 2048 + kv * 64;
    const bf16_t* vg = base + (size_t)(16 * wid + ((lane >> 2) & 7)) * INW + 2176 + kv * 64 + (lane >> 5) * 32 + (lane & 3) * 8;
    const int t_lo = (q0 - 127 > 0 ? q0 - 127 : 0) >> 6, t_hi = (q0 + 31) >> 6;
#define SWA_STAGE(t, st) do { const size_t go = (size_t)(t) * 64 * INW; const int sb_ = (st) * 32768; \
        GLDS(kg + go + kc0, sb_ + wid * 2048); GLDS(kg + go + (size_t)8 * INW + (kc0 ^ 32), sb_ + wid * 2048 + 1024); \
        GLDS(vg + go, sb_ + 16384 + wid * 2048); GLDS(vg + go + (size_t)8 * INW, sb_ + 16384 + wid * 2048 + 1024); } while (0)
    SWA_STAGE(t_lo, 0);
    __syncthreads();
    for (int t = t_lo; t <= t_hi; ++t) {
        const int st = (t - t_lo) & 1;
        if (t < t_hi) SWA_STAGE(t + 1, st ^ 1);
        const char* sb = smem + st * 32768;
        attn_tile<64, 1>(sb, sb + 16384, qr, o, m, l, t * 64, qpos, slope2, true, wsf, r32, hi, lane);
        __syncthreads();
    }
#undef SWA_STAGE
    float* ost = (float*)smem + wid * (32 * 68);
    attn_finish<64>(o, l, exp2f(p.sinks[hq] * LOG2E - m), wsf, ost, r32, hi);
    __syncthreads();
    {
        int tq = tid; asm volatile("" : "+v"(tq));
        const int q = tq >> 3, g = (tq >> 1) & 3, dh = tq & 1;
        const float* os = (const float*)smem + g * (32 * 68) + q * 68 + dh * 32;
        bf16_t* op = p.attn + tm_act(b * S + q0 + q, 512 + (kv * 4 + g) * 64 + dh * 32);
#pragma unroll
        for (int i = 0; i < 4; ++i) { const f32x4 a = *(const f32x4*)(os + 8 * i), c = *(const f32x4*)(os + 8 * i + 4);
            u32x4 w; w.x = cvtpk(a[0], a[1]); w.y = cvtpk(a[2], a[3]); w.z = cvtpk(c[0], c[1]); w.w = cvtpk(c[2], c[3]);
            *(u32x4*)(op + 8 * i) = w; }
    }
    __syncthreads();
}

constexpr int ATT_ITEMS = 4096;
__device__ __forceinline__ void attn_item(const Params& p, int item, float lam) {
    if (item < 2048) {
        const int bh = item >> 4, j = item & 15, b = bh >> 2, h = bh & 3;
        diff_unit(p, b, h, 31 - j, lam);
        diff_unit(p, b, h, j, lam);
    } else {
        const int it = item - 2048, bkv = it >> 5, qq = it & 31, b = bkv >> 1, kv = bkv & 1;
        swa_unit(p, b, kv, 2 * qq);
        swa_unit(p, b, kv, 2 * qq + 1);
    }
}

struct EpiY1 {
    static constexpr bool PERM = true;
    const float* x; const float* mod; bf16_t* y;
    __device__ __forceinline__ void operator()(f32x4 (&acc)[4][8], int mb, int nb, int lane, char*) {
        const int b = mb / S;
        const float* xb = x + (size_t)(mb + (lane & 15)) * D + nb + (lane >> 4) * 8;
        const float* gb = mod + b * MODW + G1 + nb + (lane >> 4) * 8;
        bf16_t* yb = y + (size_t)(mb + (lane & 15)) * D + nb + (lane >> 4) * 8;
        f32x4 xv[2][4][2], gv[2][2];
#define Y1_LD(dst, ptr) asm volatile("global_load_dwordx4 %0, %1, off" : "=v"(dst) : "v"(ptr))
#define Y1_ISSUE(s, g) do { Y1_LD(gv[s][0], gb + (g) * 32); Y1_LD(gv[s][1], gb + (g) * 32 + 4); \
        _Pragma("unroll") for (int i_ = 0; i_ < 4; ++i_) { Y1_LD(xv[s][i_][0], xb + (g) * 32 + (size_t)i_ * 16 * D); Y1_LD(xv[s][i_][1], xb + (g) * 32 + (size_t)i_ * 16 * D + 4); } } while (0)
#define Y1_TIE(s) "+v"(gv[s][0]), "+v"(gv[s][1]), "+v"(xv[s][0][0]), "+v"(xv[s][0][1]), "+v"(xv[s][1][0]), "+v"(xv[s][1][1]), "+v"(xv[s][2][0]), "+v"(xv[s][2][1]), "+v"(xv[s][3][0]), "+v"(xv[s][3][1])
        Y1_ISSUE(0, 0);
#pragma unroll
        for (int g = 0; g < 4; ++g) {
            const int s = g & 1;
            if (g < 3) { Y1_ISSUE(s ^ 1, g + 1);
                if (s == 0) asm volatile("s_waitcnt vmcnt(10)" : Y1_TIE(0)); else asm volatile("s_waitcnt vmcnt(10)" : Y1_TIE(1)); }
            else asm volatile("s_waitcnt vmcnt(0)" : Y1_TIE(1));
#pragma unroll
            for (int i = 0; i < 4; ++i) {
                const f32x4 y0 = xv[s][i][0] * ALPHA + gv[s][0] * acc[i][2 * g], y1v = xv[s][i][1] * ALPHA + gv[s][1] * acc[i][2 * g + 1];
                u32x4 w; w.x = cvtpk(y0[0], y0[1]); w.y = cvtpk(y0[2], y0[3]); w.z = cvtpk(y1v[0], y1v[1]); w.w = cvtpk(y1v[2], y1v[3]);
                *(u32x4*)(yb + g * 32 + (size_t)i * 16 * D) = w;
            }
        }
#undef Y1_TIE
#undef Y1_ISSUE
#undef Y1_LD
    }
};

#define DPP_ADD(v, ctrl) ((v) + __int_as_float(__builtin_amdgcn_update_dpp(0, __float_as_int(v), (ctrl), 0xf, 0xf, false)))
__device__ __forceinline__ float wave_sum(float v) {
    v = DPP_ADD(v, 0xB1);
    v = DPP_ADD(v, 0x4E);
    v = DPP_ADD(v, 0x141);
    v = DPP_ADD(v, 0x140);
    { auto r = __builtin_amdgcn_permlane16_swap(__float_as_uint(v), __float_as_uint(v), false, false); v = __uint_as_float(r[0]) + __uint_as_float(r[1]); }
    { auto r = __builtin_amdgcn_permlane32_swap(__float_as_uint(v), __float_as_uint(v), false, false); v = __uint_as_float(r[0]) + __uint_as_float(r[1]); }
    return v;
}

#define DPP_MAX(v, ctrl) fmaxf((v), __int_as_float(__builtin_amdgcn_update_dpp(0, __float_as_int(v), (ctrl), 0xf, 0xf, false)))
__device__ __forceinline__ float wave_max(float v) {
    v = DPP_MAX(v, 0xB1); v = DPP_MAX(v, 0x4E); v = DPP_MAX(v, 0x141); v = DPP_MAX(v, 0x140);
    { auto r = __builtin_amdgcn_permlane16_swap(__float_as_uint(v), __float_as_uint(v), false, false); v = fmaxf(__uint_as_float(r[0]), __uint_as_float(r[1])); }
    { auto r = __builtin_amdgcn_permlane32_swap(__float_as_uint(v), __float_as_uint(v), false, false); v = fmaxf(__uint_as_float(r[0]), __uint_as_float(r[1])); }
    return v;
}
__device__ __forceinline__ void ln1_rows(const Params& p, int r0) {
    const int tid = opaque_tid(), lane = tid & 63, wid = wave_of(tid), b = r0 / S;
    f32x4 g[4], be[4], sc[4], sh[4];
#pragma unroll
    for (int v = 0; v < 4; ++v) { const int c = 8 * lane + 512 * (v >> 1) + 4 * (v & 1); g[v] = *(const f32x4*)(p.ln1_g + c); be[v] = *(const f32x4*)(p.ln1_b + c);
        sc[v] = *(const f32x4*)(p.mod + b * MODW + SC2 + c); sh[v] = *(const f32x4*)(p.mod + b * MODW + SH2 + c); }
    u32x4 yw[4][2];
    const bf16_t* yb = p.y1 + (size_t)(r0 + wid * 32) * D + 8 * lane;
#define LN_LD(dst, ptr) asm volatile("global_load_dwordx4 %0, %1, off" : "=v"(dst) : "v"(ptr))
#define LN_ISSUE(s, row) do { const bf16_t* yp_ = yb + (size_t)(row) * D; LN_LD(yw[s][0], yp_); LN_LD(yw[s][1], yp_ + 512); } while (0)
    LN_ISSUE(0, 0); LN_ISSUE(1, 1);
#pragma unroll 1
    for (int i0 = 0; i0 < 32; i0 += 4) {
#pragma unroll
      for (int r = 0; r < 4; ++r) {
        const int i = i0 + r;
        { const int nx = (i + 2 < 32) ? i + 2 : 31; LN_ISSUE((r + 2) & 3, nx); }
        asm volatile("s_waitcnt vmcnt(4)" : "+v"(yw[r][0]), "+v"(yw[r][1]));
        const size_t ro = (size_t)(r0 + wid * 32 + i) * D;
        f32x4 v[4]; float s = 0.f;
#pragma unroll
        for (int j = 0; j < 2; ++j) { const u32x4 w4 = yw[r][j];
            v[2 * j] = (f32x4){bflo(w4.x), bfhi(w4.x), bflo(w4.y), bfhi(w4.y)}; v[2 * j + 1] = (f32x4){bflo(w4.z), bfhi(w4.z), bflo(w4.w), bfhi(w4.w)}; }
#pragma unroll
        for (int k = 0; k < 4; ++k) s += (v[k][0] + v[k][1]) + (v[k][2] + v[k][3]);
        const float mu = wave_sum(s) * (1.0f / D);
        float q = 0.f;
#pragma unroll
        for (int k = 0; k < 4; ++k) { v[k] = v[k] - mu; q += (v[k][0] * v[k][0] + v[k][1] * v[k][1]) + (v[k][2] * v[k][2] + v[k][3] * v[k][3]); }
        const float rs = rsqrtf(wave_sum(q) * (1.0f / D) + LN_EPS);
        u32x4 hw2[2];
#pragma unroll
        for (int j = 0; j < 2; ++j) {
            const f32x4 xo0 = v[2 * j] * rs * g[2 * j] + be[2 * j], xo1 = v[2 * j + 1] * rs * g[2 * j + 1] + be[2 * j + 1];
            u32x4 xw; xw.x = cvtpk(xo0[0], xo0[1]); xw.y = cvtpk(xo0[2], xo0[3]); xw.z = cvtpk(xo1[0], xo1[1]); xw.w = cvtpk(xo1[2], xo1[3]);
            *(u32x4*)(p.x1 + ro + 8 * lane + 512 * j) = xw;
            const f32x4 h0 = xo0 * (sc[2 * j] + 1.0f) + sh[2 * j], h1 = xo1 * (sc[2 * j + 1] + 1.0f) + sh[2 * j + 1];
            u32x4 w; w.x = cvtpk(h0[0], h0[1]); w.y = cvtpk(h0[2], h0[3]); w.z = cvtpk(h1[0], h1[1]); w.w = cvtpk(h1[2], h1[3]);
            *(u32x4*)(p.hbuf + tm_act(r0 + wid * 32 + i, 8 * lane + 512 * j)) = w;
            hw2[j] = w;
        }
        {
            float am = 0.f;
#pragma unroll
            for (int j = 0; j < 2; ++j)
#pragma unroll
                for (int q = 0; q < 4; ++q) am = fmaxf(am, fmaxf(fabsf(bflo(hw2[j][q])), fabsf(bfhi(hw2[j][q]))));
            am = wave_max(am);
            am = fmaxf(am, 1e-30f); const float inv = 119.0f / am;
#pragma unroll
            for (int j = 0; j < 2; ++j) {
                unsigned pa = 0u, pb = 0u;
#pragma unroll
                for (int q = 0; q < 4; ++q) {
                    const int x0 = (int)rintf(bflo(hw2[j][q]) * inv), x1 = (int)rintf(bfhi(hw2[j][q]) * inv);
                    const int b0 = ((x0 + 8) & 15) - 8, b1 = ((x1 + 8) & 15) - 8, a0 = (x0 - b0) >> 4, a1 = (x1 - b1) >> 4;
                    pa |= ((unsigned)a0 & 15u) << (8 * q); pa |= ((unsigned)a1 & 15u) << (8 * q + 4); pb |= ((unsigned)b0 & 15u) << (8 * q); pb |= ((unsigned)b1 & 15u) << (8 * q + 4);
                }
                unsigned* hp = p.hq + (size_t)(r0 + wid * 32 + i) * 256 + ((lane >> 2) + 16 * j) * 8 + (lane & 3);
                hp[0] = pa; hp[4] = pb;
            }
            if (lane == 0) p.hsc[r0 + wid * 32 + i] = am * (1.0f / 119.0f);
        }
      }
    }
    asm volatile("s_waitcnt vmcnt(0)" ::: "memory");
#undef LN_ISSUE
#undef LN_LD
}

__device__ __forceinline__ int f2ord(float v) { const int u = __float_as_int(v); return u ^ ((u >> 31) & 0x7fffffff); }
__device__ __forceinline__ float ord2f(int k) { return __int_as_float(k ^ ((k >> 31) & 0x7fffffff)); }
__device__ __forceinline__ void cex(int& a, int& b) { const int mx = max(a, b), mn = min(a, b); a = mx; b = mn; }
__device__ __forceinline__ void sort16_desc(int (&a)[16]) {
#pragma unroll
    for (int k = 2; k <= 16; k <<= 1)
#pragma unroll
        for (int j = k >> 1; j > 0; j >>= 1)
#pragma unroll
            for (int i = 0; i < 16; ++i) { const int l = i ^ j; if (l > i) { if ((i & k) == 0) cex(a[i], a[l]); else cex(a[l], a[i]); } }
}
__device__ __forceinline__ void merge16_desc(int (&a)[16]) {
#pragma unroll
    for (int j = 8; j > 0; j >>= 1)
#pragma unroll
        for (int i = 0; i < 16; ++i) { const int l = i ^ j; if (l > i) cex(a[i], a[l]); }
}
__device__ __forceinline__ void top16_merge(int (&top)[16], const int (&c)[16]) {
#pragma unroll
    for (int i = 0; i < 16; ++i) top[i] = max(top[i], c[15 - i]);
    merge16_desc(top);
}

struct EpiTopk {
    static constexpr bool PERM = false;
    int* hk; int hp0;
    __device__ __forceinline__ void operator()(f32x4 (&acc)[4][8], int mb, int nb, int lane, char* lds) {
        const int tid = opaque_tid(), wid = wave_of(tid), wm = wid >> 1, wn = wid & 1;
#pragma unroll 1
        for (int pass = 0; pass < 2; ++pass) {
            if (wn == pass) {
#pragma unroll
                for (int i = 0; i < 4; ++i) {
                    const int row = wm * 64 + i * 16 + (lane & 15);
#pragma unroll
                    for (int j = 0; j < 8; ++j) { const int c = j * 4 + (lane >> 4); *(f32x4*)(lds + row * 512 + ((c ^ (2 * (row & 7))) << 4)) = acc[i][j]; }
                }
            }
            __syncthreads();
            const int row = tid >> 1, half = tid & 1, sw = 2 * (row & 7);
            const char* rp = lds + row * 512;
            int top[16];
#pragma unroll
            for (int gq = 0; gq < 4; ++gq) {
                int c[16];
#pragma unroll
                for (int ii = 0; ii < 4; ++ii) {
                    const int ch = 2 * (4 * gq + ii) + half;
                    const f32x4 v = *(const f32x4*)(rp + ((ch ^ sw) << 4));
#pragma unroll
                    for (int e = 0; e < 4; ++e) c[4 * ii + e] = (f2ord(v[e]) & ~127) | (127 - (ch * 4 + e));
                }
                sort16_desc(c);
                if (gq == 0) {
#pragma unroll
                    for (int i = 0; i < 16; ++i) top[i] = c[i];
                } else top16_merge(top, c);
            }
            int oth[16];
#pragma unroll
            for (int i = 0; i < 16; ++i) oth[i] = __shfl_xor(top[15 - i], 1);
#pragma unroll
            for (int i = 0; i < 16; ++i) top[i] = max(top[i], oth[i]);
            merge16_desc(top);
            if (half == 0) {
                int* op = hk + ((size_t)(mb - wm * 64 + row) * 16 + hp0 + pass) * 16;
#pragma unroll
                for (int i = 0; i < 4; ++i) *(u32x4*)(op + 4 * i) = (u32x4){(unsigned)top[4 * i], (unsigned)top[4 * i + 1], (unsigned)top[4 * i + 2], (unsigned)top[4 * i + 3]};
            }
            __syncthreads();
        }
    }
};

__device__ __forceinline__ void route_combine(const Params& p, int r0) {
    const int tid = opaque_tid();
    for (int it = 0; it < 4; ++it) {
        const int th = it * 256 + tid, t = r0 + (th >> 3), h = th & 7;
        const int* ka = p.hk + ((size_t)t * 16 + 2 * h) * 16; const int* kb = ka + 16;
        float va[16], vb[16];
        int* lk = (int*)smem + tid * 33;
#pragma unroll
        for (int i = 0; i < 4; ++i) { const u32x4 a = *(const u32x4*)(ka + 4 * i), b = *(const u32x4*)(kb + 4 * i);
#pragma unroll
            for (int e = 0; e < 4; ++e) { va[4 * i + e] = ord2f((int)a[e] & ~127); vb[4 * i + e] = ord2f((int)b[e] & ~127);
                lk[4 * i + e] = (127 - ((int)a[e] & 127)) * 128; lk[16 + 4 * i + e] = 127 - ((int)b[e] & 127); } }
        int top[16];
        {
            int c[16];
#pragma unroll
            for (int j = 0; j < 16; ++j) c[j] = (f2ord(va[0] + vb[j]) & ~255) | (255 - j);
            sort16_desc(c);
#pragma unroll
            for (int i = 0; i < 16; ++i) top[i] = c[i];
#pragma unroll
            for (int j = 0; j < 8; ++j) c[j] = (f2ord(va[1] + vb[j]) & ~255) | (255 - (16 + j));
#pragma unroll
            for (int j = 0; j < 5; ++j) c[8 + j] = (f2ord(va[2] + vb[j]) & ~255) | (255 - (32 + j));
#pragma unroll
            for (int j = 0; j < 3; ++j) c[13 + j] = (f2ord(va[3] + vb[j]) & ~255) | (255 - (48 + j));
            sort16_desc(c); top16_merge(top, c);
            c[0] = (f2ord(va[3] + vb[3]) & ~255) | (255 - (48 + 3));
#pragma unroll
            for (int j = 0; j < 3; ++j) c[1 + j] = (f2ord(va[4] + vb[j]) & ~255) | (255 - (64 + j));
#pragma unroll
            for (int i = 5; i < 8; ++i)
#pragma unroll
                for (int j = 0; j < 2; ++j) c[4 + (i - 5) * 2 + j] = (f2ord(va[i] + vb[j]) & ~255) | (255 - (16 * i + j));
#pragma unroll
            for (int i = 8; i < 14; ++i) c[10 + (i - 8)] = (f2ord(va[i] + vb[0]) & ~255) | (255 - (16 * i));
            sort16_desc(c); top16_merge(top, c);
            c[0] = (f2ord(va[14] + vb[0]) & ~255) | (255 - 16 * 14); c[1] = (f2ord(va[15] + vb[0]) & ~255) | (255 - 16 * 15);
            cex(c[0], c[1]);
#pragma unroll
            for (int i = 2; i < 16; ++i) c[i] = (int)0x80000000;
            top16_merge(top, c);
        }
        float e[16], sum = 0.f; const float s0 = ord2f(top[0] & ~255);
#pragma unroll
        for (int k = 0; k < 16; ++k) { e[k] = __expf(ord2f(top[k] & ~255) - s0); sum += e[k]; }
        const float rs = 1.0f / sum;
        int* eo = p.eidx + (size_t)t * 128 + h * 16; float* go = p.gw + (size_t)t * 128 + h * 16;
#pragma unroll
        for (int k = 0; k < 16; ++k) { const int pos = 255 - (top[k] & 255); eo[k] = lk[pos >> 4] + lk[16 + (pos & 15)]; go[k] = e[k] * rs; }
    }
}

typedef __bf16 bf16x2_t __attribute__((ext_vector_type(2)));
__device__ __forceinline__ float dot2bf(unsigned a, unsigned b, float c) { return __builtin_amdgcn_fdot2_f32_bf16(__builtin_bit_cast(bf16x2_t, a), __builtin_bit_cast(bf16x2_t, b), c, false); }
__device__ __forceinline__ float gelu_erf(float s) { return 0.5f * s * (1.0f + erff(s * 0.70710678118654752f)); }

#define DPP_IADD(v, ctrl) ((v) + __builtin_amdgcn_update_dpp(0, (v), (ctrl), 0xf, 0xf, false))
__device__ __forceinline__ int wave_isum(int v) {
    v = DPP_IADD(v, 0xB1); v = DPP_IADD(v, 0x4E); v = DPP_IADD(v, 0x141); v = DPP_IADD(v, 0x140);
    { auto r = __builtin_amdgcn_permlane16_swap((unsigned)v, (unsigned)v, false, false); v = (int)(r[0] + r[1]); }
    { auto r = __builtin_amdgcn_permlane32_swap((unsigned)v, (unsigned)v, false, false); v = (int)(r[0] + r[1]); }
    return v;
}
__device__ __forceinline__ float ub0(unsigned w) { return (float)(w & 0xffu); }
__device__ __forceinline__ float ub1(unsigned w) { return (float)((w >> 8) & 0xffu); }
__device__ __forceinline__ float ub2(unsigned w) { return (float)((w >> 16) & 0xffu); }
__device__ __forceinline__ float ub3(unsigned w) { return (float)(w >> 24); }

constexpr int PEER_LVEC = 12288;
constexpr int PEER_LDS = PEER_LVEC + 4 * 16384;
__device__ __forceinline__ void peer_u(const Params& p, int t0, int ntok, int lane) {
    const int li = lane & 31, li16 = li * 16; const bool hi = lane >= 32;
    u32x4 buf[16]; unsigned mbuf[16];
#define PEV(esel, base, j) ({ const int ea__ = __builtin_amdgcn_readlane(esel, (base) + 2 * (j)), eb__ = __builtin_amdgcn_readlane(esel, (base) + 2 * (j) + 1); hi ? eb__ : ea__; })
#define PFU(j, esel, base) do { const int ev_ = PEV(esel, base, j); const int ro_ = ev_ * 512 + li16, mo_ = ev_ * 32 + li;        \
        asm volatile("global_load_dwordx4 %0, %1, %2" : "=v"(buf[j]) : "v"(ro_), "s"(p.u_q)); \
        asm volatile("global_load_ubyte %0, %1, %2" : "=v"(mbuf[j]) : "v"(mo_), "s"(p.u_m)); } while (0)
#define MBYTE(j) ({ asm volatile("s_waitcnt vmcnt(22)" : "+v"(mbuf[j])); mbuf[j]; })
#define DATA_R(j) ({ asm volatile("s_waitcnt vmcnt(22)" : "+v"(buf[j])); buf[j]; })
#define H_LOAD(tt) do { const u32x4 ha_ = *(const u32x4*)(p.hq + (size_t)(tt) * 256 + li * 8), hb_ = *(const u32x4*)(p.hq + (size_t)(tt) * 256 + li * 8 + 4); \
            _Pragma("unroll") for (int k = 0; k < 4; ++k) { hA[k] = ha_[k]; hB[k] = hb_[k]; } hs = p.hsc[(tt)]; } while (0)
    int e0 = p.eidx[(size_t)t0 * 128 + lane], e1 = p.eidx[(size_t)t0 * 128 + 64 + lane];
#pragma unroll
    for (int j = 0; j < 16; ++j) PFU(j, e0, 0);
    unsigned hA[4], hB[4]; float hs;
    H_LOAD(t0);
    asm volatile("s_waitcnt vmcnt(0)" ::: "memory");
#pragma unroll 1
    for (int it = 0; it < ntok; ++it) {
        const int t = t0 + it;
        const int tn = (it + 1 < ntok) ? t + 1 : t;
        const int e0n = p.eidx[(size_t)tn * 128 + lane], e1n = p.eidx[(size_t)tn * 128 + 64 + lane];
        if (it) H_LOAD(t);
        const float g0 = p.gw[(size_t)t * 128 + lane], g1 = p.gw[(size_t)t * 128 + 64 + lane], us0 = p.u_sc[e0], us1 = p.u_sc[e1], vs0 = p.v_sc[e0] * 255.0f, vs1 = p.v_sc[e1] * 255.0f;
        int sA = 0, sB = 0;
#define DPPM(v, ctrl) __builtin_amdgcn_update_dpp(0, (v), (ctrl), 0xf, 0xf, false)
#define PA_BLOCK(jb, DATA, PREFETCH) do { int sq_[4]; \
            _Pragma("unroll") for (int q = 0; q < 4; ++q) { const int j_ = 4 * (jb) + q; const u32x4 dd_ = DATA(j_); int sa2_ = 0, sb2_ = 0; \
                _Pragma("unroll") for (int k = 0; k < 4; ++k) { sa2_ = __builtin_amdgcn_sdot8((int)hA[k], (int)dd_[k], sa2_, false); sb2_ = __builtin_amdgcn_sdot8((int)hB[k], (int)dd_[k], sb2_, false); } \
                sq_[q] = __mul24((sa2_ << 4) + sb2_, (int)MBYTE(j_)); PREFETCH(j_); }       \
            const int r0_ = (b0_ ? sq_[2] : sq_[0]) + DPPM(b0_ ? sq_[0] : sq_[2], 0xB1), r1_ = (b0_ ? sq_[3] : sq_[1]) + DPPM(b0_ ? sq_[1] : sq_[3], 0xB1); \
            int u_ = (b1_ ? r1_ : r0_) + DPPM(b1_ ? r0_ : r1_, 0x4E);              \
            u_ += DPPM(u_, 0x124); u_ += DPPM(u_, 0x128);                         \
            { auto r_ = __builtin_amdgcn_permlane16_swap((unsigned)u_, (unsigned)u_, false, false); u_ = (int)(r_[0] + r_[1]); }     \
            { auto r_ = __builtin_amdgcn_permlane32_swap((unsigned)u_, (unsigned)u_, false, false); const int lo_ = (int)r_[0], hi_ = (int)r_[1];    \
                \
              const int gl_ = b2_ ? DPPM(lo_, 0xF5) : DPPM(lo_, 0xA0), gh_ = b2_ ? DPPM(hi_, 0xF5) : DPPM(hi_, 0xA0); \
              const int val_ = b0_ ? gh_ : gl_; sT = ((lrel >> 3) == (jb)) ? val_ : sT; } \
            __builtin_amdgcn_sched_barrier(0); } while (0)
        asm volatile(".p2align 6\n\ts_nop 0\n\ts_nop 0\n\ts_nop 0\n\ts_nop 0\n\ts_nop 0\n\ts_nop 0\n\ts_nop 0\n\ts_nop 0\n\ts_nop 0\n\ts_nop 0\n\ts_nop 0\n\ts_nop 0\n\ts_nop 0\n\ts_nop 0\n\ts_nop 0");
#pragma unroll 1
        for (int g = 0; g < 4; ++g) {
            int lane_ = lane; asm volatile("" : "+v"(lane_));
            int en_ = (g == 0) ? e0 : ((g == 3) ? e0n : e1); asm volatile("" : "+v"(en_));
            const int nb_ = (g & 1) ? 0 : 32;
            int sT = (g < 2) ? sA : sB;
            const bool b0_ = lane_ & 1, b1_ = lane_ & 2, b2_ = lane_ & 4;
            const int lrel = lane_ - 32 * (g & 1);
#define PF(j) PFU(j, en_, nb_)
#pragma unroll
            for (int jb = 0; jb < 4; ++jb) PA_BLOCK(jb, DATA_R, PF);
#undef PF
            if (g < 2) sA = sT; else sB = sT;
        }
#undef PA_BLOCK
#undef DPPM
        p.gw[(size_t)t * 128 + lane] = g0 * gelu_erf((float)sA * (hs * us0)) * vs0;
        p.gw[(size_t)t * 128 + 64 + lane] = g1 * gelu_erf((float)sB * (hs * us1)) * vs1;
        e0 = e0n; e1 = e1n;
    }
#undef PEV
#undef PFU
#undef MBYTE
#undef DATA_R
#undef H_LOAD
}

__device__ __forceinline__ void peer_v(const Params& p, int t0, int ntok, int lane, int wid, float* outbase, size_t tmask, const float* lvec  ) {
    const int li = lane & 31; const bool hi = lane >= 32;
    const int lring = PEER_LVEC + wid * 16384;
    int lx16[4];
#pragma unroll
    for (int s4 = 0; s4 < 4; ++s4) lx16[s4] = (li ^ (2 * s4 + (hi ? 1 : 0))) * 16;
#define ISSUE_V(s, esel, ln) do { const int ea__ = __builtin_amdgcn_readlane(esel, (ln)), eb__ = __builtin_amdgcn_readlane(esel, (ln) + 1); const int ev_ = hi ? eb__ : ea__; \
        const unsigned char* gp_ = p.v_q + (size_t)ev_ * 512 + lx16[(s) & 3]; \
        __builtin_amdgcn_global_load_lds((const unsigned*)gp_, (__attribute__((address_space(3))) unsigned*)(smem + lring + (s) * 1024), 16, 0, 0); } while (0)
    const int trr = (lane & 15) >> 1, trc = lane & 1, trg = lane >> 4;
    const unsigned tr_base = (unsigned)(size_t)(lds_cptr)(smem + lring + (trr >> 1) * 1024 + (trr & 1) * 512 + ((trg ^ (trr & 3)) << 4) + trc * 8);
    const unsigned trE = tr_base + ((trr >> 2) ? 64u : 0u), trO = tr_base - ((trr >> 2) ? 64u : 0u);
#define TRB8(dst, va, OFF) asm volatile("ds_read_b64_tr_b8 %0, %1 offset:%2" : "=v"(dst) : "v"(va), "n"(OFF) : "memory")
    int e0 = p.eidx[(size_t)t0 * 128 + lane], e1 = p.eidx[(size_t)t0 * 128 + 64 + lane];
    float wA = p.gw[(size_t)t0 * 128 + lane], wB = p.gw[(size_t)t0 * 128 + 64 + lane];
#pragma unroll
    for (int s = 0; s < 16; ++s) ISSUE_V(s, e0, 2 * s);
    asm volatile("s_waitcnt vmcnt(0)" ::: "memory");
#pragma unroll 1
    for (int it = 0; it < ntok; ++it) {
        const int t = t0 + it;
        const int tn = (it + 1 < ntok) ? t + 1 : t;
        const int e0n = p.eidx[(size_t)tn * 128 + lane], e1n = p.eidx[(size_t)tn * 128 + 64 + lane];
        const float wAn = p.gw[(size_t)tn * 128 + lane], wBn = p.gw[(size_t)tn * 128 + 64 + lane];
        float wmax = fmaxf(fabsf(wA), fabsf(wB));
#pragma unroll
        for (int o = 32; o > 0; o >>= 1) wmax = fmaxf(wmax, __shfl_xor(wmax, o));
        const float Sw = fmaxf(wmax * (1.0f / 127.0f), 1e-30f), invS = 1.0f / Sw;
        const int wqa = (int)rintf(wA * invS), wqb = (int)rintf(wB * invS);
        const int wqsum = wave_isum(wqa + wqb);
        int WpA = (wqa & 0xff) << (8 * (lane & 3)), WpB = (wqb & 0xff) << (8 * (lane & 3));
        WpA |= __builtin_amdgcn_update_dpp(0, WpA, 0xB1, 0xf, 0xf, false); WpA |= __builtin_amdgcn_update_dpp(0, WpA, 0x4E, 0xf, 0xf, false);
        WpB |= __builtin_amdgcn_update_dpp(0, WpB, 0xB1, 0xf, 0xf, false); WpB |= __builtin_amdgcn_update_dpp(0, WpB, 0x4E, 0xf, 0xf, false);
        int acci[16];
#pragma unroll
        for (int i = 0; i < 16; ++i) acci[i] = 0;
#define VB_BATCH(b) do { \
            asm volatile("s_waitcnt vmcnt(12)" ::: "memory"); \
            const int wl_ = 8 * ((4 * Bq + (b)) & 7); \
            const int W0_ = __builtin_amdgcn_readlane(wsel_, wl_), W1_ = __builtin_amdgcn_readlane(wsel_, wl_ + 4); \
            u32x2 d_[8]; \
            TRB8(d_[0], trE, (b) * 4096 + 0);   TRB8(d_[1], trO, (b) * 4096 + 64);  TRB8(d_[2], trE, (b) * 4096 + 128); TRB8(d_[3], trO, (b) * 4096 + 192); \
            TRB8(d_[4], trE, (b) * 4096 + 256); TRB8(d_[5], trO, (b) * 4096 + 320); TRB8(d_[6], trE, (b) * 4096 + 384); TRB8(d_[7], trO, (b) * 4096 + 448); \
            asm volatile("s_waitcnt lgkmcnt(0)" : "+v"(d_[0]), "+v"(d_[1]), "+v"(d_[2]), "+v"(d_[3]), "+v"(d_[4]), "+v"(d_[5]), "+v"(d_[6]), "+v"(d_[7])); \
            _Pragma("unroll") for (int s_ = 0; s_ < 4; ++s_) ISSUE_V(4 * (b) + s_, vsel_, vln_ + 2 * (4 * (b) + s_));        \
            _Pragma("unroll") for (int i = 0; i < 8; ++i) { \
                const unsigned lo0 = d_[i].x & 0x0F0F0F0Fu, hi0 = (d_[i].x >> 4) & 0x0F0F0F0Fu, lo1 = d_[i].y & 0x0F0F0F0Fu, hi1 = (d_[i].y >> 4) & 0x0F0F0F0Fu; \
                acci[2 * i] = __builtin_amdgcn_sdot4((int)lo0, W0_, acci[2 * i], false); acci[2 * i] = __builtin_amdgcn_sdot4((int)lo1, W1_, acci[2 * i], false); \
                acci[2 * i + 1] = __builtin_amdgcn_sdot4((int)hi0, W0_, acci[2 * i + 1], false); acci[2 * i + 1] = __builtin_amdgcn_sdot4((int)hi1, W1_, acci[2 * i + 1], false); } \
            __builtin_amdgcn_sched_barrier(0); } while (0)
#pragma unroll 1
        for (int Bq = 0; Bq < 4; ++Bq) {
            int wsel_ = (Bq < 2) ? WpA : WpB; int vsel_ = (Bq == 0) ? e0 : ((Bq == 3) ? e0n : e1); asm volatile("" : "+v"(wsel_), "+v"(vsel_));
            const int vln_ = ((Bq + 1) & 1) * 32;
            VB_BATCH(0); VB_BATCH(1); VB_BATCH(2); VB_BATCH(3);
        }
#undef VB_BATCH
        float* outp = outbase + ((size_t)t & tmask) * D;
        const int c0 = 32 * (lane >> 4) + 2 * (lane & 15);
        typedef float f32x2 __attribute__((ext_vector_type(2)));
        unsigned xw[8];
#pragma unroll
        for (int i = 0; i < 8; ++i) xw[i] = *(const unsigned*)(p.x1 + (size_t)t * D + c0 + 128 * i);
        float y[16]; float s = 0.f;
#pragma unroll
        for (int i = 0; i < 8; ++i) {
            const f32x2 g2 = *(const f32x2*)(lvec + c0 + 128 * i);
            const float f0 = (float)(acci[2 * i] - 8 * wqsum) * Sw, f1 = (float)(acci[2 * i + 1] - 8 * wqsum) * Sw;
            const float v0 = ALPHA * bflo(xw[i]) + g2[0] * f0, v1 = ALPHA * bfhi(xw[i]) + g2[1] * f1;
            y[2 * i] = v0; y[2 * i + 1] = v1; s += v0 + v1;
        }
        const float mu = wave_sum(s) * (1.0f / D);
        float q = 0.f;
#pragma unroll
        for (int i = 0; i < 16; ++i) { y[i] -= mu; q += y[i] * y[i]; }
        const float rsd = rsqrtf(wave_sum(q) * (1.0f / D) + LN_EPS);
#pragma unroll
        for (int i = 0; i < 8; ++i) {
            const f32x2 gg = *(const f32x2*)(lvec + 1024 + c0 + 128 * i), bb = *(const f32x2*)(lvec + 2048 + c0 + 128 * i);
            f32x2 o; o[0] = y[2 * i] * rsd * gg[0] + bb[0]; o[1] = y[2 * i + 1] * rsd * gg[1] + bb[1];
            *(f32x2*)(outp + c0 + 128 * i) = o;
        }
        e0 = e0n; e1 = e1n; wA = wAn; wB = wBn;
    }
#undef ISSUE_V
#undef TRB8
}


#define XB_TMO      128
#define XB_XCNT(j)  (256  + 64 * (j))
#define XB_XSUB(j)  (1280 + 64 * (j))
#define XB_XGEN(j)  (2304 + 64 * (j))
#define XB_TOP      3328
#define XB_TOPGEN   3392
#define XCD_BAR_WORDS 3456
#define XB_SPIN_CAP (1u << 20)
#define LAS __attribute__((address_space(3)))
__device__ __forceinline__ unsigned xb_ld(unsigned* p)              { return __hip_atomic_load(p, __ATOMIC_RELAXED, __HIP_MEMORY_SCOPE_AGENT); }
__device__ __forceinline__ unsigned xb_add(unsigned* p, unsigned v) { return __hip_atomic_fetch_add(p, v, __ATOMIC_RELAXED, __HIP_MEMORY_SCOPE_AGENT); }
__device__ __forceinline__ unsigned xb_xcc_id() { return (unsigned)__builtin_amdgcn_s_getreg((3 << 11) | 20) & 0xFu; }
#define XB_SPIN(cond, bar) do { unsigned _sp = 0; while (cond) { __builtin_amdgcn_s_sleep(1); \
    if ((++_sp & 255u) == 0u) { if (xb_ld(&(bar)[XB_TMO])) break; if (_sp > XB_SPIN_CAP) { atomicAdd(&(bar)[XB_TMO], 1u); break; } } } } while (0)
struct XcdBarrier { unsigned* bar; unsigned x; volatile LAS unsigned* st; };
__device__ __forceinline__ XcdBarrier xcd_barrier_post(unsigned* bar, volatile LAS unsigned* st) {
    XcdBarrier b; b.bar = bar; b.x = xb_xcc_id(); b.st = st;
    if (threadIdx.x == 0) (void)xb_add(&bar[XB_XCNT(b.x)], 1u);
    return b;
}
__device__ __forceinline__ void xcd_barrier_complete(unsigned* bar, unsigned x, unsigned& nloc, unsigned& nx) {
    const unsigned G = gridDim.x * gridDim.y * gridDim.z;
    unsigned sum, cnt, mine, sp = 0u;
    for (;;) {
        sum = 0u; cnt = 0u; mine = 0u;
#pragma unroll
        for (unsigned j = 0; j < 16; ++j) { const unsigned c = xb_ld(&bar[XB_XCNT(j)]); sum += c; cnt += (c > 0u) ? 1u : 0u; mine = (j == x) ? c : mine; }
        if (sum == G) break;
        __builtin_amdgcn_s_sleep(1);
        if ((++sp & 255u) == 0u) { if (xb_ld(&bar[XB_TMO])) break; if (sp > XB_SPIN_CAP) { atomicAdd(&bar[XB_TMO], 1u); break; } }
    }
    nloc = mine > 0u ? mine : 1u; nx = cnt > 0u ? cnt : 1u;
}
__device__ __forceinline__ void xcd_barrier(const XcdBarrier& b) {
    asm volatile("s_waitcnt vmcnt(0)" ::: "memory");
    __syncthreads();
    if (threadIdx.x == 0) {
        unsigned* bar = b.bar;
        __builtin_amdgcn_s_waitcnt(0);
        unsigned nloc = b.st[0], nx = b.st[1];
        if (nloc == 0u) { xcd_barrier_complete(bar, b.x, nloc, nx); b.st[0] = nloc; b.st[1] = nx; }
        const unsigned old = xb_add(&bar[XB_XSUB(b.x)], 1u);
        const unsigned gen = old / nloc;
        if (old + 1u == (gen + 1u) * nloc) {
            __builtin_amdgcn_fence(__ATOMIC_RELEASE, "agent");
            asm volatile("s_waitcnt vmcnt(0)" ::: "memory");
            const unsigned og = xb_add(&bar[XB_TOP], 1u);
            const unsigned tg = og / nx;
            if (og + 1u == (tg + 1u) * nx) xb_add(&bar[XB_TOPGEN], 1u);
            else XB_SPIN(xb_ld(&bar[XB_TOPGEN]) == tg, bar);
            __builtin_amdgcn_fence(__ATOMIC_ACQUIRE, "agent");
            xb_add(&bar[XB_XGEN(b.x)], 1u);
            asm volatile("s_waitcnt vmcnt(0)" ::: "memory");
        } else {
            XB_SPIN(xb_ld(&bar[XB_XGEN(b.x)]) == gen, bar);
            __builtin_amdgcn_fence(__ATOMIC_ACQUIRE, "agent");
            asm volatile("s_waitcnt vmcnt(0)" ::: "memory");
        }
    }
    __syncthreads();
}

constexpr int MEGA_LDS0 = ATT_LDS > GEMM_LDS ? ATT_LDS : GEMM_LDS;
constexpr int MEGA_LDS = MEGA_LDS0 > PEER_LDS ? MEGA_LDS0 : PEER_LDS;
__global__ __launch_bounds__(256, 2) void mega_fwd(Params p) {
    cooperative_groups::grid_group grid = cooperative_groups::this_grid();
    const int nblk = gridDim.x, bid = blockIdx.x;
    volatile LAS unsigned* xst = (volatile LAS unsigned*)(smem + MEGA_LDS);
    if (threadIdx.x == 0) { xst[0] = 0u; xst[1] = 0u; }
    __syncthreads();
    const XcdBarrier xb = xcd_barrier_post(p.bar, xst);
    for (int it = bid; it < PREP_MOD; it += nblk) mod_item(p, it);
    if (__builtin_expect(p.out == nullptr, 0)) grid.sync();
    xcd_barrier(xb);
    if ((bid >> 3) & 1) {
        for (int it = bid; it < PREP_REST; it += nblk) prep_item(p, it);
        for (int mt = bid; mt < T / 128; mt += nblk) modulate_rows(p.x, p.mod, SH1, SC1, p.hbuf, mt * 128, 128);
    } else {
        for (int mt = bid; mt < T / 128; mt += nblk) modulate_rows(p.x, p.mod, SH1, SC1, p.hbuf, mt * 128, 128);
        for (int it = bid; it < PREP_REST; it += nblk) prep_item(p, it);
    }
    xcd_barrier(xb);
    {
        const int x = bid & 7, rank = bid >> 3, per = nblk >> 3;
        EpiProj epi{p.proj};
        for (int mt = rank; mt < T / 128; mt += per) gemm_tile(p.hbuf, p.w_in_t, INW, mt * 128, x * 256, smem, epi);
        for (int mt = bid; mt < T / 128; mt += nblk) gemm_tile(p.hbuf, p.w_in_t, INW, mt * 128, 8 * 256, smem, epi);
    }
    xcd_barrier(xb);
    {
        const float lam = p.scal[0];
        const int xcd = bid & 7, rank = bid >> 3, per = nblk >> 3;
        for (int r0 = 0; r0 < ATT_ITEMS; r0 += nblk) { const int item = r0 + xcd * per + rank; if (item < ATT_ITEMS) attn_item(p, item, lam); }
    }
    xcd_barrier(xb);
    for (int mt = bid; mt < T / 128; mt += nblk) {
        { EpiY1 epi{p.x, p.mod, p.y1};
          for (int nt = 0; nt < D / 256; ++nt) gemm_tile(p.attn, p.w_out_t, D, mt * 128, nt * 256, smem, epi); }
        __syncthreads();
        ln1_rows(p, mt * 128);
        __syncthreads();
        for (int nt = 0; nt < 8; ++nt) { EpiTopk epi{p.hk, 2 * nt}; gemm_tile(p.hbuf, p.weff_t, 2048, mt * 128, nt * 256, smem, epi); }
        __syncthreads();
        route_combine(p, mt * 128);
        __syncthreads();
        const int ptid = opaque_tid(), lane = ptid & 63, wid = wave_of(ptid);
        peer_u(p, mt * 128 + wid * 32, 32, lane);
        __syncthreads();
    }
    xcd_barrier(xb);
    for (int mt = bid; mt < T / 128; mt += nblk) {
        const int ptid = opaque_tid(), lane = ptid & 63, wid = wave_of(ptid);
        {
            float* lv = (float*)smem; const int bb = (mt * 128) / S;
            *(f32x4*)(lv + ptid * 4) = *(const f32x4*)(p.mod + bb * MODW + G2 + ptid * 4);
            *(f32x4*)(lv + 1024 + ptid * 4) = *(const f32x4*)(p.ln2_g + ptid * 4);
            *(f32x4*)(lv + 2048 + ptid * 4) = *(const f32x4*)(p.ln2_b + ptid * 4);
            __syncthreads();
        }
        peer_v(p, mt * 128 + wid * 32, 32, lane, wid, p.out, ~(size_t)0, (const float*)smem);
        __syncthreads();
    }
}
}

extern "C" void kernel_launch(void* const* d_in, const int* in_sizes, int n_in, void* d_out, int out_size, void* d_ws, size_t ws_size, hipStream_t stream) {
    Params p{};
    p.x = (const float*)d_in[0]; p.c = (const float*)d_in[1]; p.w_ada = (const float*)d_in[2]; p.b_ada = (const float*)d_in[3];
    p.w_in = (const float*)d_in[4]; p.lq1 = (const float*)d_in[5]; p.lk1 = (const float*)d_in[6]; p.lq2 = (const float*)d_in[7]; p.lk2 = (const float*)d_in[8];
    p.subln_g = (const float*)d_in[9]; p.sinks = (const float*)d_in[10]; p.w_out = (const float*)d_in[11]; p.ln1_g = (const float*)d_in[12]; p.ln1_b = (const float*)d_in[13];
    p.w_pq = (const float*)d_in[14]; p.sub_keys = (const float*)d_in[15]; p.u_tab = (const float*)d_in[16]; p.v_tab = (const float*)d_in[17];
    p.ln2_g = (const float*)d_in[18]; p.ln2_b = (const float*)d_in[19];
    p.out = (float*)d_out;
    char* ws = (char*)d_ws; const size_t MiB = 1ull << 20;
    p.mod = (float*)(ws);
    p.bar = (unsigned*)(ws + 768 * 1024);
    p.scal = (float*)(ws + 768 * 1024 + 16384);
    p.w_in_t = (bf16_t*)(ws + 1 * MiB);
    p.w_out_t = (bf16_t*)(ws + 6 * MiB);
    p.weff_t = (bf16_t*)(ws + 8 * MiB);
    p.u_q = (unsigned char*)(ws + 12 * MiB);
    p.v_q = (unsigned char*)(ws + 28 * MiB);
    p.u_sc = (float*)(ws + 44 * MiB);
    p.v_sc = (float*)(ws + 44 * MiB + 65536);
    p.v_m = (unsigned char*)(ws + 45 * MiB);
    p.u_m = (unsigned char*)(ws + 46 * MiB);
    p.hbuf = (bf16_t*)(ws + 76 * MiB);
    p.proj = (bf16_t*)(ws + 204 * MiB);
    p.attn = (bf16_t*)(ws + 492 * MiB);
    p.x1 = p.attn;
    p.y1 = (bf16_t*)(ws + 332 * MiB);
    p.hq = (unsigned*)(ws + 620 * MiB);
    p.hsc = (float*)(ws + 684 * MiB);
    p.hk = (int*)(ws + 204 * MiB);
    p.eidx = (int*)(ws + 268 * MiB);
    p.gw = (float*)(ws + 300 * MiB);

    static int grid_blocks = 0;
    if (!grid_blocks) {
        int dev = 0, cus = 0, per_cu = 0;
        (void)hipGetDevice(&dev);
        (void)hipDeviceGetAttribute(&cus, hipDeviceAttributeMultiprocessorCount, dev);
        (void)hipFuncSetAttribute((const void*)mega_fwd, hipFuncAttributeMaxDynamicSharedMemorySize, MEGA_LDS + 16);
        (void)hipOccupancyMaxActiveBlocksPerMultiprocessor(&per_cu, mega_fwd, 256, MEGA_LDS + 16);
        if (per_cu > 2) per_cu = 2;
        grid_blocks = cus * per_cu;
        grid_blocks -= grid_blocks % 8;
    }
    (void)hipMemsetAsync(p.bar, 0, XCD_BAR_WORDS * sizeof(unsigned), stream);
    void* args[] = {&p};
    hipError_t e = hipLaunchCooperativeKernel((const void*)mega_fwd, dim3(grid_blocks), dim3(256), args, MEGA_LDS + 16, stream);
    if (e != hipSuccess) fprintf(stderr, "cooperative launch failed: %s (grid %d)\n", hipGetErrorString(e), grid_blocks);
}
```

```cpp
#include <hip/hip_runtime.h>
#include <hip/hip_cooperative_groups.h>
#include <stdint.h>
#include <cstdio>

namespace {
typedef unsigned short bf16_t;
typedef short bf16x8 __attribute__((ext_vector_type(8)));
typedef short s16x4 __attribute__((ext_vector_type(4)));
typedef float f32x4 __attribute__((ext_vector_type(4)));
typedef float f32x16 __attribute__((ext_vector_type(16)));
typedef unsigned u32x4 __attribute__((ext_vector_type(4)));
typedef unsigned u32x2 __attribute__((ext_vector_type(2)));
constexpr float LOG2E = 1.4426950408889634f;
constexpr float QSCALE = 0.125f * LOG2E;
typedef __bf16 bf16pair_t __attribute__((ext_vector_type(2)));
__device__ __forceinline__ unsigned cvtpk(float lo, float hi) { bf16pair_t v; v[0] = (__bf16)lo; v[1] = (__bf16)hi; return __builtin_bit_cast(unsigned, v); }
__device__ __forceinline__ int opaque_tid() { int t = threadIdx.x; asm volatile("" : "+v"(t)); return t; }
__device__ __forceinline__ int wave_of(int tid) { return __builtin_amdgcn_readfirstlane(tid >> 6); }
__device__ __forceinline__ float bf2f(bf16_t b) { return __uint_as_float((unsigned)b << 16); }
__device__ __forceinline__ float bflo(unsigned w) { return __uint_as_float(w << 16); }
__device__ __forceinline__ float bfhi(unsigned w) { return __uint_as_float(w & 0xffff0000u); }

constexpr int D = 1024, NB = 32, S = 2048, T = NB * S;
constexpr int INW = 2304, MODW = 6144;
constexpr float LN_EPS = 1e-5f;
constexpr float ALPHA = 1.189207115002721f;
constexpr float LAMBDA_INIT = 0.2f;
constexpr int SH1 = 0, SC1 = 1024, G1 = 2048, SH2 = 3072, SC2 = 4096, G2 = 5120;
__device__ __forceinline__ size_t tm_act(int r, int k) { return (size_t)(r >> 7) * 131072 + (size_t)((k >> 5) * 4096 + (r & 127) * 32 + (k & 31)); }
__device__ __forceinline__ size_t tm_w(int n, int k, int N) { return ((size_t)(k >> 5) * N + n) * 32 + (k & 31); }


struct Params {
    const float *x, *c, *w_ada, *b_ada, *w_in, *lq1, *lk1, *lq2, *lk2, *subln_g, *sinks, *w_out, *ln1_g, *ln1_b, *w_pq, *sub_keys, *u_tab, *v_tab, *ln2_g, *ln2_b;
    float* out;
    float* mod;
    bf16_t* w_in_t;
    bf16_t* w_out_t;
    bf16_t* weff_t;
    unsigned char* u_q;
    unsigned char* v_q;
    float* u_sc;
    unsigned char* u_m;
    unsigned char* v_m;
    float* v_sc;
    bf16_t* hbuf;
    bf16_t* proj;
    bf16_t* attn;
    bf16_t* y1;
    unsigned* hq;
    float* hsc;
    bf16_t* x1;
    int* hk;
    int* eidx;
    float* gw;
    unsigned* bar;
    float* scal;
};

extern __shared__ __attribute__((aligned(16))) char smem[];

constexpr int PREP_MOD = 384;
constexpr int PREP_TIN = 16 * 36;
constexpr int PREP_TOUT = 16 * 16;
constexpr int PREP_WEFF = 16 * 2 * 32;
constexpr int PREP_CVT = 512;
constexpr int PREP_REST = PREP_TIN + PREP_TOUT + PREP_WEFF + 2 * PREP_CVT;

__device__ __forceinline__ void tr_tile(const float* __restrict__ src, int N, int K, bf16_t* __restrict__ dst, int kt, int nt, float* lds) {
    const int tid = opaque_tid();
#pragma unroll
    for (int i = 0; i < 16; ++i) { const int idx = tid + i * 256, r = idx >> 6, cc = idx & 63; lds[r * 65 + cc] = src[(size_t)(kt * 64 + r) * N + nt * 64 + cc]; }
    __syncthreads();
#pragma unroll
    for (int i = 0; i < 16; ++i) { const int idx = tid + i * 256, n = idx >> 6, k = idx & 63; dst[tm_w(nt * 64 + n, kt * 64 + k, N)] = (bf16_t)(cvtpk(lds[k * 65 + n], 0.f) & 0xffffu); }
    __syncthreads();
}

__device__ __forceinline__ void mod_item(const Params& p, int item) {
    const int tid = opaque_tid(), lane = tid & 63, wid = wave_of(tid);
    float* lds = (float*)smem;
    const int cb = item >> 2, bg = item & 3, j = cb * 64 + lane;
    for (int i = tid; i < 8192; i += 256) { const int b = i >> 10, k = i & 1023; const float v = p.c[(bg * 8 + b) * D + k]; lds[k * 8 + b] = v / (1.0f + expf(-v)); }
    __syncthreads();
    float acc[8];
#pragma unroll
    for (int b = 0; b < 8; ++b) acc[b] = 0.f;
    const float* wp = p.w_ada + (size_t)(wid * 256) * MODW + j;
#pragma unroll 4
    for (int k = 0; k < 256; ++k) {
        const float wv = wp[(size_t)k * MODW];
        const f32x4 s0 = *(const f32x4*)(lds + (wid * 256 + k) * 8), s1 = *(const f32x4*)(lds + (wid * 256 + k) * 8 + 4);
        acc[0] += s0[0] * wv; acc[1] += s0[1] * wv; acc[2] += s0[2] * wv; acc[3] += s0[3] * wv;
        acc[4] += s1[0] * wv; acc[5] += s1[1] * wv; acc[6] += s1[2] * wv; acc[7] += s1[3] * wv;
    }
    float* red = lds + 8192;
#pragma unroll
    for (int b = 0; b < 8; ++b) red[(wid * 8 + b) * 64 + lane] = acc[b];
    __syncthreads();
#pragma unroll
    for (int r = 0; r < 2; ++r) {
        const int o = tid + 256 * r, b = o >> 6, col = o & 63;
        const float s = (red[(0 * 8 + b) * 64 + col] + red[(1 * 8 + b) * 64 + col]) + (red[(2 * 8 + b) * 64 + col] + red[(3 * 8 + b) * 64 + col]);
        p.mod[(bg * 8 + b) * MODW + cb * 64 + col] = s + p.b_ada[cb * 64 + col];
    }
    if (item == 0 && tid == 0) {
        float s1 = 0.f, s2 = 0.f;
        for (int i = 0; i < 64; ++i) { s1 += p.lq1[i] * p.lk1[i]; s2 += p.lq2[i] * p.lk2[i]; }
        p.scal[0] = expf(s1) - expf(s2) + LAMBDA_INIT;
    }
    __syncthreads();
}

__device__ __forceinline__ void prep_item(const Params& p, int item) {
    const int tid = opaque_tid();
    float* lds = (float*)smem;
    if (item < PREP_TIN) { tr_tile(p.w_in, INW, D, p.w_in_t, item / 36, item % 36, lds); return; }
    item -= PREP_TIN;
    if (item < PREP_TOUT) { tr_tile(p.w_out, D, D, p.w_out_t, item / 16, item % 16, lds); return; }
    item -= PREP_TOUT;
    if (item < PREP_WEFF) {
        const int hp = item >> 6, nh = (item >> 5) & 1, ct = item & 31;
        float* ks = lds;
        float* wsm = lds + 64 * 129;
        for (int i = tid; i < 64 * 128; i += 256) { const int n = i >> 7, d = i & 127; ks[n * 129 + d] = p.sub_keys[((size_t)hp * 128 + nh * 64 + n) * 128 + d]; }
        for (int i = tid; i < 32 * 128; i += 256) { const int cc = i >> 7, d = i & 127; wsm[cc * 128 + d] = p.w_pq[(size_t)(ct * 32 + cc) * 2048 + hp * 128 + d]; }
        __syncthreads();
        const int n = tid & 63, cb = (tid >> 6) * 8;
        float acc[8];
#pragma unroll
        for (int cc = 0; cc < 8; ++cc) acc[cc] = 0.f;
        for (int d = 0; d < 128; ++d) { const float kv = ks[n * 129 + d];
#pragma unroll
            for (int cc = 0; cc < 8; ++cc) acc[cc] += kv * wsm[(cb + cc) * 128 + d]; }
        u32x4 w; w.x = cvtpk(acc[0], acc[1]); w.y = cvtpk(acc[2], acc[3]); w.z = cvtpk(acc[4], acc[5]); w.w = cvtpk(acc[6], acc[7]);
        *(u32x4*)(p.weff_t + tm_w(hp * 128 + nh * 64 + n, ct * 32 + cb, 2048)) = w;
        __syncthreads();
        return;
    }
    item -= PREP_WEFF;
    {
        const bool isv = item >= PREP_CVT;
        const float* src = isv ? p.v_tab : p.u_tab; unsigned char* dst = isv ? p.v_q : p.u_q; unsigned char* mdst = isv ? p.v_m : p.u_m; float* scl = isv ? p.v_sc : p.u_sc;
        const int lane = tid & 63, wid = wave_of(tid);
        for (int i0 = 0; i0 < 8; i0 += 4) {
            f32x4 vv[4][4];
#pragma unroll
            for (int r = 0; r < 4; ++r) { const float* rp = src + (size_t)((item % PREP_CVT) * 32 + wid * 8 + i0 + r) * D + lane * 16;
#pragma unroll
                for (int j = 0; j < 4; ++j) vv[r][j] = *(const f32x4*)(rp + 4 * j); }
#pragma unroll
            for (int r = 0; r < 4; ++r) {
                const int e = (item % PREP_CVT) * 32 + wid * 8 + i0 + r;
                float gm = 0.f;
#pragma unroll
                for (int j = 0; j < 4; ++j) gm = fmaxf(gm, fmaxf(fmaxf(fabsf(vv[r][j][0]), fabsf(vv[r][j][1])), fmaxf(fabsf(vv[r][j][2]), fabsf(vv[r][j][3]))));
                float am = gm;
#pragma unroll
                for (int o = 32; o > 0; o >>= 1) am = fmaxf(am, __shfl_xor(am, o));
                am = fmaxf(am, 1e-30f);
                gm = fmaxf(gm, __shfl_xor(gm, 1));
                int mq = (int)ceilf(gm * 255.0f / am); mq = mq < 1 ? 1 : (mq > 255 ? 255 : mq); if (isv) mq = 255;
                const float gi = 7.0f * 255.0f / (am * (float)mq);
                unsigned w0 = 0u, w1 = 0u;
#pragma unroll
                for (int j = 0; j < 4; ++j)
#pragma unroll
                    for (int q = 0; q < 4; ++q) {
                        int n = (int)rintf(vv[r][j][q] * gi); n = n < -7 ? -7 : (n > 7 ? 7 : n); n = isv ? n + 8 : (n & 15);
                        const int idx = 4 * j + q;
                        if (idx < 8) w0 |= (unsigned)n << (4 * idx); else w1 |= (unsigned)n << (4 * (idx - 8));
                    }
                u32x2 ww; ww.x = w0; ww.y = w1;
                *(u32x2*)(dst + (size_t)e * 512 + lane * 8) = ww;
                if ((lane & 1) == 0) mdst[(size_t)e * 32 + (lane >> 1)] = (unsigned char)mq;
                if (lane == 0) scl[e] = am * (1.0f / (255.0f * 7.0f));
            }
        }
    }
}

__device__ __forceinline__ void modulate_rows(const float* __restrict__ x, const float* __restrict__ mod, int sh_off, int sc_off, bf16_t* __restrict__ h, int r0, int nrows) {
    const int tid = opaque_tid();
    for (int i = tid; i < nrows * 128; i += 256) {
        const int r = r0 + (i >> 7), k = (i & 127) * 8, b = r / S;
        const float* xp = x + (size_t)r * D + k; const float* sc = mod + b * MODW + sc_off + k; const float* sh = mod + b * MODW + sh_off + k;
        const float4 x0 = *(const float4*)xp, x1v = *(const float4*)(xp + 4), c0 = *(const float4*)sc, c1 = *(const float4*)(sc + 4), s0 = *(const float4*)sh, s1 = *(const float4*)(sh + 4);
        u32x4 w;
        w.x = cvtpk(x0.x * (1.f + c0.x) + s0.x, x0.y * (1.f + c0.y) + s0.y); w.y = cvtpk(x0.z * (1.f + c0.z) + s0.z, x0.w * (1.f + c0.w) + s0.w);
        w.z = cvtpk(x1v.x * (1.f + c1.x) + s1.x, x1v.y * (1.f + c1.y) + s1.y); w.w = cvtpk(x1v.z * (1.f + c1.z) + s1.z, x1v.w * (1.f + c1.w) + s1.w);
        *(u32x4*)(h + tm_act(r, k)) = w;
    }
}

constexpr int GEMM_STAGE = 24576;
constexpr int GEMM_LDS = 3 * GEMM_STAGE;
constexpr int GK = 1024;
#define GLDS16(gp, off) __builtin_amdgcn_global_load_lds((const unsigned*)(gp), (__attribute__((address_space(3))) unsigned*)(smem + (off)), 16, 0, 0)
template <class Epi>
__device__ __forceinline__ void gemm_tile(const bf16_t* __restrict__ A, const bf16_t* __restrict__ Bt, int BN, int m0, int n0, char* lds, Epi& epi) {
    const int tid = opaque_tid(), lane = tid & 63, wid = wave_of(tid), wm = wid >> 1, wn = wid & 1;
    const int swz = (((lane & 3) ^ ((0 - (lane >> 4)) & 3)) * 8), r16 = lane >> 2;
    const int goff = r16 * 32 + swz;
    const int goffB = Epi::PERM ? (8 * (r16 >> 2) + (r16 & 3)) * 32 + swz : goff;
    constexpr int BQ1 = Epi::PERM ? 4 * 32 : 16 * 32, BQ2 = 32 * 32, BQ3 = Epi::PERM ? 36 * 32 : 48 * 32;
    const bf16_t* Ab = A + (size_t)m0 * GK + wid * 1024 + goff; const bf16_t* Bb = Bt + (size_t)(n0 + wid * 64) * 32 + goffB;
    const int bks = BN * 32;
    const int dstA = wid * 2048, dstB = 8192 + wid * 4096;
    const int fsw = (((lane >> 4) ^ (0 - ((lane & 15) >> 2))) & 3) * 16;
    const int fa = (wm * 64 + (lane & 15)) * 64 + fsw, fb = 8192 + (wn * 128 + (lane & 15)) * 64 + fsw;
    f32x4 acc[4][8];
#pragma unroll
    for (int i = 0; i < 4; ++i)
#pragma unroll
        for (int j = 0; j < 8; ++j) acc[i][j] = (f32x4){0.f, 0.f, 0.f, 0.f};
    constexpr int nk = GK / 32;
#define GEMM_STAGE_LOAD(kt, st) do { const int so_ = (st) * GEMM_STAGE; \
        GLDS16(Ab + (kt) * 4096, so_ + dstA); GLDS16(Ab + (kt) * 4096 + 512, so_ + dstA + 1024); const bf16_t* bq_ = Bb + (size_t)(kt) * bks; \
        GLDS16(bq_, so_ + dstB); GLDS16(bq_ + BQ1, so_ + dstB + 1024); GLDS16(bq_ + BQ2, so_ + dstB + 2048); GLDS16(bq_ + BQ3, so_ + dstB + 3072); } while (0)
    GEMM_STAGE_LOAD(0, 0);
    GEMM_STAGE_LOAD(1, 1);
    int cur = 0, nx2 = 2 * GEMM_STAGE;
#pragma unroll 1
    for (int kt = 0; kt < nk; ++kt) {
        if (kt + 1 < nk) asm volatile("s_waitcnt vmcnt(6)" ::: "memory"); else asm volatile("s_waitcnt vmcnt(0)" ::: "memory");
        __builtin_amdgcn_s_barrier();
        asm volatile("" ::: "memory");
        bf16x8 af[4], bfr[8];
#pragma unroll
        for (int i = 0; i < 4; ++i) af[i] = *(const bf16x8*)(lds + cur + fa + i * 1024);
#pragma unroll
        for (int j = 0; j < 8; ++j) bfr[j] = *(const bf16x8*)(lds + cur + fb + j * 1024);
        __builtin_amdgcn_sched_barrier(0);
        if (kt + 2 < nk) { const int so_ = nx2;
            GLDS16(Ab + (kt + 2) * 4096, so_ + dstA); GLDS16(Ab + (kt + 2) * 4096 + 512, so_ + dstA + 1024); const bf16_t* bq_ = Bb + (size_t)(kt + 2) * bks;
            GLDS16(bq_, so_ + dstB); GLDS16(bq_ + BQ1, so_ + dstB + 1024); GLDS16(bq_ + BQ2, so_ + dstB + 2048); GLDS16(bq_ + BQ3, so_ + dstB + 3072); }
        __builtin_amdgcn_sched_barrier(0);
#pragma unroll
        for (int j = 0; j < 8; ++j)
#pragma unroll
            for (int i = 0; i < 4; ++i) acc[i][j] = __builtin_amdgcn_mfma_f32_16x16x32_bf16(bfr[j], af[i], acc[i][j], 0, 0, 0);
        nx2 = cur; cur = (cur == 2 * GEMM_STAGE) ? 0 : cur + GEMM_STAGE;
    }
    __syncthreads();
#undef GEMM_STAGE_LOAD
    epi(acc, m0 + wm * 64, n0 + wn * 128, lane, lds);
}

struct EpiProj {
    static constexpr bool PERM = true;
    bf16_t* out;
    __device__ __forceinline__ void operator()(f32x4 (&acc)[4][8], int mb, int nb, int lane, char*) {
#pragma unroll
        for (int g = 0; g < 4; ++g) {
            const int col = nb + g * 32 + (lane >> 4) * 8;
            const float sc = (col < 512 || (col >= 1536 && col < 2048)) ? QSCALE : 1.0f;
#pragma unroll
            for (int i = 0; i < 4; ++i) {
                const int row = mb + i * 16 + (lane & 15);
                const f32x4 a = acc[i][2 * g], c = acc[i][2 * g + 1];
                u32x4 w; w.x = cvtpk(a[0] * sc, a[1] * sc); w.y = cvtpk(a[2] * sc, a[3] * sc); w.z = cvtpk(c[0] * sc, c[1] * sc); w.w = cvtpk(c[2] * sc, c[3] * sc);
                *(u32x4*)(out + (size_t)row * INW + col) = w;
            }
        }
    }
};


constexpr int ATT_WS = 69632;
constexpr int ATT_LDS = ATT_WS + 4 * 256;
#define MFMA32(a, b, c) __builtin_amdgcn_mfma_f32_32x32x16_bf16(a, b, c, 0, 0, 0)
typedef short v4i16_t __attribute__((ext_vector_type(4)));
typedef __attribute__((address_space(3))) const char* lds_cptr;
__device__ __forceinline__ s16x4 vtr(const char* p) { return __builtin_bit_cast(s16x4, __builtin_amdgcn_ds_read_tr16_b64_v4i16((__attribute__((address_space(3))) v4i16_t*)(lds_cptr)p)); }
__device__ __forceinline__ int crow(int r, int hi) { return (r & 3) + 8 * (r >> 2) + 4 * hi; }
__device__ __forceinline__ float max3f(float a, float b, float c) { float r; asm("v_max3_f32 %0, %1, %2, %3" : "=v"(r) : "v"(a), "v"(b), "v"(c)); return r; }
__device__ __forceinline__ float rowmax32(const f32x16& p0, const f32x16& p1) {
    float x0 = p0[0], x1 = p1[0]; asm volatile("s_nop 7\n\ts_nop 3" : "+v"(x0), "+v"(x1));
    float a = max3f(x0, p0[1], p0[2]), b = max3f(x1, p1[1], p1[2]);
#pragma unroll
    for (int r = 3; r < 15; r += 2) { a = max3f(a, p0[r], p0[r + 1]); b = max3f(b, p1[r], p1[r + 1]); }
    a = max3f(a, p0[15], b); a = fmaxf(a, p1[15]);
    auto rr = __builtin_amdgcn_permlane32_swap(__float_as_uint(a), __float_as_uint(a), false, false);
    return fmaxf(__uint_as_float(rr[0]), __uint_as_float(rr[1]));
}

struct VFrag { u32x2 lo, hh; };
#define VTR1(dst, va, OFF) asm volatile("ds_read_b64_tr_b16 %0, %1 offset:%2" : "=v"(dst) : "v"(va), "n"(OFF) : "memory")
template <int DV, int KS>
__device__ __forceinline__ void vload(VFrag (&f)[DV / 32], unsigned va) {
    constexpr int KBS = (DV / 32) * 512;
    VTR1(f[0].lo, va, (2 * KS) * KBS); VTR1(f[0].hh, va, (2 * KS + 1) * KBS);
    VTR1(f[1].lo, va, (2 * KS) * KBS + 512); VTR1(f[1].hh, va, (2 * KS + 1) * KBS + 512);
    if constexpr (DV == 128) {
        VTR1(f[2].lo, va, (2 * KS) * KBS + 1024); VTR1(f[2].hh, va, (2 * KS + 1) * KBS + 1024);
        VTR1(f[3].lo, va, (2 * KS) * KBS + 1536); VTR1(f[3].hh, va, (2 * KS + 1) * KBS + 1536);
    }
}
template <int DV, int N>
__device__ __forceinline__ void vwait(VFrag (&f)[DV / 32]) {
    if constexpr (DV == 128) asm volatile("s_waitcnt lgkmcnt(%8)" : "+v"(f[0].lo), "+v"(f[0].hh), "+v"(f[1].lo), "+v"(f[1].hh), "+v"(f[2].lo), "+v"(f[2].hh), "+v"(f[3].lo), "+v"(f[3].hh) : "n"(N));
    else asm volatile("s_waitcnt lgkmcnt(%4)" : "+v"(f[0].lo), "+v"(f[0].hh), "+v"(f[1].lo), "+v"(f[1].hh) : "n"(N));
}
template <int DV, int KS>
__device__ __forceinline__ void pv_step(VFrag (&cur)[DV / 32], VFrag (&nxt)[DV / 32], unsigned va, const u32x4& pw, f32x16 (&o)[DV / 32]) {
    if constexpr (KS < 3) { vload<DV, KS + 1>(nxt, va); vwait<DV, 2 * (DV / 32)>(cur); } else vwait<DV, 0>(cur);
    const bf16x8 pa = __builtin_bit_cast(bf16x8, pw);
#pragma unroll
    for (int db = 0; db < DV / 32; ++db) {
        const u32x4 w = (u32x4){cur[db].lo.x, cur[db].lo.y, cur[db].hh.x, cur[db].hh.y};
        o[db] = MFMA32(pa, __builtin_bit_cast(bf16x8, w), o[db]);
    }
}
template <int DV, int MODE>
__device__ __forceinline__ void attn_tile(const char* kimg, const char* vimg, const bf16x8 (&qr)[4], f32x16 (&o)[DV / 32], float& m, float& l, int k0, int qpos, float slope2,
                                          bool need_mask, float* wsf, int r32, int hi, int lane) {
    const char* kp = kimg + r32 * 128; const int kx = (r32 >> 1) & 7;
    const unsigned va = (unsigned)(size_t)(lds_cptr)(vimg + ((lane >> 4) & 1) * 32 + (lane & 3) * 8 + (4 * hi + ((lane & 15) >> 2)) * 64);
    VFrag va0[DV / 32], va1[DV / 32];
    vload<DV, 0>(va0, va);
    const float base0 = slope2 * (float)(k0 + 4 * hi - qpos) - m;
    f32x16 c0, c1;
#pragma unroll
    for (int r = 0; r < 16; ++r) { const float cst = (float)((r & 3) + 8 * (r >> 2)); c0[r] = fmaf(slope2, cst, base0); c1[r] = fmaf(slope2, cst + 32.0f, base0); }
    bf16x8 kf[8];
#pragma unroll
    for (int d0 = 0; d0 < 4; ++d0) { const int po = ((2 * d0 + hi) ^ kx) * 16; kf[2 * d0] = *(const bf16x8*)(kp + po); kf[2 * d0 + 1] = *(const bf16x8*)(kp + 4096 + po); }
    __builtin_amdgcn_sched_barrier(0);
#pragma unroll
    for (int d0 = 0; d0 < 4; ++d0) { c0 = MFMA32(kf[2 * d0], qr[d0], c0); c1 = MFMA32(kf[2 * d0 + 1], qr[d0], c1); }
    if (need_mask) {
        const int kb = k0 + 4 * hi;
#pragma unroll
        for (int r = 0; r < 16; ++r) {
            const int key = kb + (r & 3) + 8 * (r >> 2);
            bool v0 = key <= qpos, v1 = key + 32 <= qpos;
            if (MODE == 1) { v0 = v0 && (key > qpos - 128); v1 = v1 && (key + 32 > qpos - 128); }
            c0[r] = v0 ? c0[r] : -INFINITY; c1[r] = v1 ? c1[r] : -INFINITY;
        }
    }
    const float rm = rowmax32(c0, c1);
    if (__any(rm > 8.0f)) {
        const float delta = fmaxf(rm, 0.f); m += delta; const float alpha = exp2f(-delta); l *= alpha;
#pragma unroll
        for (int r = 0; r < 16; ++r) { c0[r] -= delta; c1[r] -= delta; }
        if (hi == 0) wsf[r32] = alpha;
        __builtin_amdgcn_s_waitcnt(0xc07f);
        int q4 = 4 * hi; asm volatile("" : "+v"(q4));
        const float* wb = wsf + q4;
#pragma unroll
        for (int r = 0; r < 16; ++r) { const float a = wb[(r & 3) + 8 * (r >> 2)];
#pragma unroll
            for (int db = 0; db < DV / 32; ++db) o[db][r] *= a; }
    }
#pragma unroll
    for (int r = 0; r < 16; ++r) { c0[r] = __builtin_amdgcn_exp2f(c0[r]); c1[r] = __builtin_amdgcn_exp2f(c1[r]); }
    {
        typedef float f32x2 __attribute__((ext_vector_type(2)));
        f32x2 t[8];
#pragma unroll
        for (int r = 0; r < 8; ++r) t[r] = (f32x2){c0[2 * r], c0[2 * r + 1]} + (f32x2){c1[2 * r], c1[2 * r + 1]};
#pragma unroll
        for (int r = 0; r < 4; ++r) t[r] = t[r] + t[r + 4];
        t[0] = (t[0] + t[2]) + (t[1] + t[3]);
        l += t[0].x + t[0].y;
    }
    u32x4 pw[4];
#pragma unroll
    for (int s = 0; s < 2; ++s) {
        pw[s] = (u32x4){cvtpk(c0[8 * s], c0[8 * s + 1]), cvtpk(c0[8 * s + 2], c0[8 * s + 3]), cvtpk(c0[8 * s + 4], c0[8 * s + 5]), cvtpk(c0[8 * s + 6], c0[8 * s + 7])};
        pw[2 + s] = (u32x4){cvtpk(c1[8 * s], c1[8 * s + 1]), cvtpk(c1[8 * s + 2], c1[8 * s + 3]), cvtpk(c1[8 * s + 4], c1[8 * s + 5]), cvtpk(c1[8 * s + 6], c1[8 * s + 7])};
    }
    pv_step<DV, 0>(va0, va1, va, pw[0], o);
    pv_step<DV, 1>(va1, va0, va, pw[1], o);
    pv_step<DV, 2>(va0, va1, va, pw[2], o);
    pv_step<DV, 3>(va1, va0, va, pw[3], o);
}

template <int DV>
__device__ __forceinline__ void attn_finish(f32x16 (&o)[DV / 32], float l, float extra, float* wsf, float* ost, int r32, int hi) {
    auto rr = __builtin_amdgcn_permlane32_swap(__float_as_uint(l), __float_as_uint(l), false, false);
    const float lt = __uint_as_float(rr[0]) + __uint_as_float(rr[1]) + extra;
    if (hi == 0) wsf[32 + r32] = 1.0f / lt;
    __builtin_amdgcn_s_waitcnt(0xc07f);
    int q4 = 4 * hi; asm volatile("" : "+v"(q4));
    const float* wb = wsf + 32 + q4; float* ob = ost + q4 * (DV + 4) + r32;
#pragma unroll
    for (int r = 0; r < 16; ++r) { const int qc = (r & 3) + 8 * (r >> 2); const float a = wb[qc];
#pragma unroll
        for (int db = 0; db < DV / 32; ++db) ob[qc * (DV + 4) + db * 32] = o[db][r] * a; }
}

__device__ __forceinline__ void diff_unit(const Params& p, int b, int h, int qblk, float lam) {
    const int tid = opaque_tid(), lane = tid & 63, wid = wave_of(tid), r32 = lane & 31, hi = lane >> 5, map = wid >> 1, chunk = wid & 1;
    const bf16_t* base = p.proj + (size_t)b * S * INW;
    const int q0 = qblk * 64 + chunk * 32, qpos = q0 + r32;
    const float slope2 = exp2f(-8.0f * (float)(9 + h) / 12.0f) * LOG2E;
    float* wsf = (float*)(smem + ATT_WS) + wid * 64;
    bf16x8 qr[4];
    { const bf16_t* qp = base + (size_t)qpos * INW + h * 128 + map * 64 + hi * 8;
#pragma unroll
      for (int d0 = 0; d0 < 4; ++d0) qr[d0] = *(const bf16x8*)(qp + d0 * 16); }
    f32x16 o[4];
#pragma unroll
    for (int db = 0; db < 4; ++db) o[db] = f32x16{};
    float m = 0.f, l = 0.f;
    const int kc0 = ((lane & 7) ^ (lane >> 4)) * 8;
    const bf16_t* kg = base + (size_t)(32 * (wid & 1) + (lane >> 3)) * INW + 512 + h * 128 + (wid >> 1) * 64;
    const bf16_t* vg = base + (size_t)(32 * (wid & 1) + ((lane >> 2) & 7)) * INW + 1024 + h * 128 + (wid >> 1) * 64 + (lane >> 5) * 32 + (lane & 3) * 8;
    const int kdst = (wid >> 1) * 8192 + (wid & 1) * 4096, vdst = 16384 + (wid & 1) * 8192 + (wid >> 1) * 1024;
    const int nt = qblk + 1;
#define GLDS(gp, off) __builtin_amdgcn_global_load_lds((const unsigned*)(gp), (__attribute__((address_space(3))) unsigned*)(smem + (off)), 16, 0, 0)
#define DIFF_STAGE(t, st) do { const size_t go = (size_t)(t) * 64 * INW; const int sb_ = (st) * 32768; \
        GLDS(kg + go + kc0, sb_ + kdst); GLDS(kg + go + (size_t)8 * INW + (kc0 ^ 32), sb_ + kdst + 1024); \
        GLDS(kg + go + (size_t)16 * INW + kc0, sb_ + kdst + 2048); GLDS(kg + go + (size_t)24 * INW + (kc0 ^ 32), sb_ + kdst + 3072); \
        _Pragma("unroll") for (int kb = 0; kb < 4; ++kb) GLDS(vg + go + (size_t)kb * 8 * INW, sb_ + vdst + kb * 2048); } while (0)
    DIFF_STAGE(0, 0);
    __syncthreads();
    for (int t = 0; t < nt; ++t) {
        if (t + 1 < nt) DIFF_STAGE(t + 1, (t + 1) & 1);
        const char* sb = smem + (t & 1) * 32768;
        attn_tile<128, 0>(sb + map * 8192, sb + 16384, qr, o, m, l, t * 64, qpos, slope2, t * 64 + 63 > q0, wsf, r32, hi, lane);
        __syncthreads();
    }
#undef DIFF_STAGE
    float* ost = (float*)smem + wid * (32 * 132);
    attn_finish<128>(o, l, 0.f, wsf, ost, r32, hi);
    __syncthreads();
    {
        int tq = tid; asm volatile("" : "+v"(tq));
        const int q = tq >> 2, dq = tq & 3, ch = q >> 5, qi = q & 31;
        const float* o1 = (const float*)smem + ch * (32 * 132) + qi * 132 + dq * 32;
        const float* o2 = (const float*)smem + (2 + ch) * (32 * 132) + qi * 132 + dq * 32;
        float v[32]; float ss = 0.f;
#pragma unroll
        for (int i = 0; i < 8; ++i) { const f32x4 a = *(const f32x4*)(o1 + 4 * i), c = *(const f32x4*)(o2 + 4 * i);
#pragma unroll
            for (int e = 0; e < 4; ++e) { const float x = a[e] - lam * c[e]; v[4 * i + e] = x; ss += x * x; } }
        ss += __shfl_xor(ss, 1); ss += __shfl_xor(ss, 2);
        const float rn = rsqrtf(ss * (1.0f / 128.0f) + LN_EPS) * (1.0f - LAMBDA_INIT);
        const float* g = p.subln_g + dq * 32;
        bf16_t* op = p.attn + tm_act(b * S + qblk * 64 + q, h * 128 + dq * 32);
#pragma unroll
        for (int i = 0; i < 4; ++i) { u32x4 w;
            w.x = cvtpk(v[8 * i] * rn * g[8 * i], v[8 * i + 1] * rn * g[8 * i + 1]); w.y = cvtpk(v[8 * i + 2] * rn * g[8 * i + 2], v[8 * i + 3] * rn * g[8 * i + 3]);
            w.z = cvtpk(v[8 * i + 4] * rn * g[8 * i + 4], v[8 * i + 5] * rn * g[8 * i + 5]); w.w = cvtpk(v[8 * i + 6] * rn * g[8 * i + 6], v[8 * i + 7] * rn * g[8 * i + 7]);
            *(u32x4*)(op + 8 * i) = w; }
    }
    __syncthreads();
}

__device__ __forceinline__ void swa_unit(const Params& p, int b, int kv, int qc) {
    const int tid = opaque_tid(), lane = tid & 63, wid = wave_of(tid), r32 = lane & 31, hi = lane >> 5, hq = kv * 4 + wid;
    const bf16_t* base = p.proj + (size_t)b * S * INW;
    const int q0 = qc * 32, qpos = q0 + r32;
    const float slope2 = exp2f(-8.0f * (float)(1 + hq) / 12.0f) * LOG2E;
    float* wsf = (float*)(smem + ATT_WS) + wid * 64;
    bf16x8 qr[4];
    { const bf16_t* qp = base + (size_t)qpos * INW + 1536 + hq * 64 + hi * 8;
#pragma unroll
      for (int d0 = 0; d0 < 4; ++d0) qr[d0] = *(const bf16x8*)(qp + d0 * 16); }
    f32x16 o[2]; o[0] = f32x16{}; o[1] = f32x16{};
    float m = 0.f, l = 0.f;
    const int kc0 = ((lane & 7) ^ (lane >> 4)) * 8;
    const bf16_t* kg = base + (size_t)(16 * wid + (lane >> 3)) * INW + 2048 + kv * 64;
    const bf16_t* vg = base + (size_t)(16 * wid + ((lane >> 2) & 7)) * INW + 2176 + kv * 64 + (lane >> 5) * 32 + (lane & 3) * 8;
    const int t_lo = (q0 - 127 > 0 ? q0 - 127 : 0) >> 6, t_hi = (q0 + 31) >> 6;
#define SWA_STAGE(t, st) do { const size_t go = (size_t)(t) * 64 * INW; const int sb_ = (st) * 32768; \
        GLDS(kg + go + kc0, sb_ + wid * 2048); GLDS(kg + go + (size_t)8 * INW + (kc0 ^ 32), sb_ + wid * 2048 + 1024); \
        GLDS(vg + go, sb_ + 16384 + wid * 2048); GLDS(vg + go + (size_t)8 * INW, sb_ + 16384 + wid * 2048 + 1024); } while (0)
    SWA_STAGE(t_lo, 0);
    __syncthreads();
    for (int t = t_lo; t <= t_hi; ++t) {
        const int st = (t - t_lo) & 1;
        if (t < t_hi) SWA_STAGE(t + 1, st ^ 1);
        const char* sb = smem + st * 32768;
        attn_tile<64, 1>(sb, sb + 16384, qr, o, m, l, t * 64, qpos, slope2, true, wsf, r32, hi, lane);
        __syncthreads();
    }
#undef SWA_STAGE
    float* ost = (float*)smem + wid * (32 * 68);
    attn_finish<64>(o, l, exp2f(p.sinks[hq] * LOG2E - m), wsf, ost, r32, hi);
    __syncthreads();
    {
        int tq = tid; asm volatile("" : "+v"(tq));
        const int q = tq >> 3, g = (tq >> 1) & 3, dh = tq & 1;
        const float* os = (const float*)smem + g * (32 * 68) + q * 68 + dh * 32;
        bf16_t* op = p.attn + tm_act(b * S + q0 + q, 512 + (kv * 4 + g) * 64 + dh * 32);
#pragma unroll
        for (int i = 0; i < 4; ++i) { const f32x4 a = *(const f32x4*)(os + 8 * i), c = *(const f32x4*)(os + 8 * i + 4);
            u32x4 w; w.x = cvtpk(a[0], a[1]); w.y = cvtpk(a[2], a[3]); w.z = cvtpk(c[0], c[1]); w.w = cvtpk(c[2], c[3]);
            *(u32x4*)(op + 8 * i) = w; }
    }
    __syncthreads();
}

constexpr int ATT_ITEMS = 4096;
__device__ __forceinline__ void attn_item(const Params& p, int item, float lam) {
    if (item < 2048) {
        const int bh = item >> 4, j = item & 15, b = bh >> 2, h = bh & 3;
        diff_unit(p, b, h, 31 - j, lam);
        diff_unit(p, b, h, j, lam);
    } else {
        const int it = item - 2048, bkv = it >> 5, qq = it & 31, b = bkv >> 1, kv = bkv & 1;
        swa_unit(p, b, kv, 2 * qq);
        swa_unit(p, b, kv, 2 * qq + 1);
    }
}

struct EpiY1 {
    static constexpr bool PERM = true;
    const float* x; const float* mod; bf16_t* y;
    __device__ __forceinline__ void operator()(f32x4 (&acc)[4][8], int mb, int nb, int lane, char*) {
        const int b = mb / S;
        const float* xb = x + (size_t)(mb + (lane & 15)) * D + nb + (lane >> 4) * 8;
        const float* gb = mod + b * MODW + G1 + nb + (lane >> 4) * 8;
        bf16_t* yb = y + (size_t)(mb + (lane & 15)) * D + nb + (lane >> 4) * 8;
        f32x4 xv[2][4][2], gv[2][2];
#define Y1_LD(dst, ptr) asm volatile("global_load_dwordx4 %0, %1, off" : "=v"(dst) : "v"(ptr))
#define Y1_ISSUE(s, g) do { Y1_LD(gv[s][0], gb + (g) * 32); Y1_LD(gv[s][1], gb + (g) * 32 + 4); \
        _Pragma("unroll") for (int i_ = 0; i_ < 4; ++i_) { Y1_LD(xv[s][i_][0], xb + (g) * 32 + (size_t)i_ * 16 * D); Y1_LD(xv[s][i_][1], xb + (g) * 32 + (size_t)i_ * 16 * D + 4); } } while (0)
#define Y1_TIE(s) "+v"(gv[s][0]), "+v"(gv[s][1]), "+v"(xv[s][0][0]), "+v"(xv[s][0][1]), "+v"(xv[s][1][0]), "+v"(xv[s][1][1]), "+v"(xv[s][2][0]), "+v"(xv[s][2][1]), "+v"(xv[s][3][0]), "+v"(xv[s][3][1])
        Y1_ISSUE(0, 0);
#pragma unroll
        for (int g = 0; g < 4; ++g) {
            const int s = g & 1;
            if (g < 3) { Y1_ISSUE(s ^ 1, g + 1);
                if (s == 0) asm volatile("s_waitcnt vmcnt(10)" : Y1_TIE(0)); else asm volatile("s_waitcnt vmcnt(10)" : Y1_TIE(1)); }
            else asm volatile("s_waitcnt vmcnt(0)" : Y1_TIE(1));
#pragma unroll
            for (int i = 0; i < 4; ++i) {
                const f32x4 y0 = xv[s][i][0] * ALPHA + gv[s][0] * acc[i][2 * g], y1v = xv[s][i][1] * ALPHA + gv[s][1] * acc[i][2 * g + 1];
                u32x4 w; w.x = cvtpk(y0[0], y0[1]); w.y = cvtpk(y0[2], y0[3]); w.z = cvtpk(y1v[0], y1v[1]); w.w = cvtpk(y1v[2], y1v[3]);
                *(u32x4*)(yb + g * 32 + (size_t)i * 16 * D) = w;
            }
        }
#undef Y1_TIE
#undef Y1_ISSUE
#undef Y1_LD
    }
};

#define DPP_ADD(v, ctrl) ((v) + __int_as_float(__builtin_amdgcn_update_dpp(0, __float_as_int(v), (ctrl), 0xf, 0xf, false)))
__device__ __forceinline__ float wave_sum(float v) {
    v = DPP_ADD(v, 0xB1);
    v = DPP_ADD(v, 0x4E);
    v = DPP_ADD(v, 0x141);
    v = DPP_ADD(v, 0x140);
    { auto r = __builtin_amdgcn_permlane16_swap(__float_as_uint(v), __float_as_uint(v), false, false); v = __uint_as_float(r[0]) + __uint_as_float(r[1]); }
    { auto r = __builtin_amdgcn_permlane32_swap(__float_as_uint(v), __float_as_uint(v), false, false); v = __uint_as_float(r[0]) + __uint_as_float(r[1]); }
    return v;
}

#define DPP_MAX(v, ctrl) fmaxf((v), __int_as_float(__builtin_amdgcn_update_dpp(0, __float_as_int(v), (ctrl), 0xf, 0xf, false)))
__device__ __forceinline__ float wave_max(float v) {
    v = DPP_MAX(v, 0xB1); v = DPP_MAX(v, 0x4E); v = DPP_MAX(v, 0x141); v = DPP_MAX(v, 0x140);
    { auto r = __builtin_amdgcn_permlane16_swap(__float_as_uint(v), __float_as_uint(v), false, false); v = fmaxf(__uint_as_float(r[0]), __uint_as_float(r[1])); }
    { auto r = __builtin_amdgcn_permlane32_swap(__float_as_uint(v), __float_as_uint(v), false, false); v = fmaxf(__uint_as_float(r[0]), __uint_as_float(r[1])); }
    return v;
}
__device__ __forceinline__ void ln1_rows(const Params& p, int r0) {
    const int tid = opaque_tid(), lane = tid & 63, wid = wave_of(tid), b = r0 / S;
    f32x4 g[4], be[4], sc[4], sh[4];
#pragma unroll
    for (int v = 0; v < 4; ++v) { const int c = 8 * lane + 512 * (v >> 1) + 4 * (v & 1); g[v] = *(const f32x4*)(p.ln1_g + c); be[v] = *(const f32x4*)(p.ln1_b + c);
        sc[v] = *(const f32x4*)(p.mod + b * MODW + SC2 + c); sh[v] = *(const f32x4*)(p.mod + b * MODW + SH2 + c); }
    u32x4 yw[4][2];
    const bf16_t* yb = p.y1 + (size_t)(r0 + wid * 32) * D + 8 * lane;
#define LN_LD(dst, ptr) asm volatile("global_load_dwordx4 %0, %1, off" : "=v"(dst) : "v"(ptr))
#define LN_ISSUE(s, row) do { const bf16_t* yp_ = yb + (size_t)(row) * D; LN_LD(yw[s][0], yp_); LN_LD(yw[s][1], yp_ + 512); } while (0)
    LN_ISSUE(0, 0); LN_ISSUE(1, 1);
#pragma unroll 1
    for (int i0 = 0; i0 < 32; i0 += 4) {
#pragma unroll
      for (int r = 0; r < 4; ++r) {
        const int i = i0 + r;
        { const int nx = (i + 2 < 32) ? i + 2 : 31; LN_ISSUE((r + 2) & 3, nx); }
        asm volatile("s_waitcnt vmcnt(4)" : "+v"(yw[r][0]), "+v"(yw[r][1]));
        const size_t ro = (size_t)(r0 + wid * 32 + i) * D;
        f32x4 v[4]; float s = 0.f;
#pragma unroll
        for (int j = 0; j < 2; ++j) { const u32x4 w4 = yw[r][j];
            v[2 * j] = (f32x4){bflo(w4.x), bfhi(w4.x), bflo(w4.y), bfhi(w4.y)}; v[2 * j + 1] = (f32x4){bflo(w4.z), bfhi(w4.z), bflo(w4.w), bfhi(w4.w)}; }
#pragma unroll
        for (int k = 0; k < 4; ++k) s += (v[k][0] + v[k][1]) + (v[k][2] + v[k][3]);
        const float mu = wave_sum(s) * (1.0f / D);
        float q = 0.f;
#pragma unroll
        for (int k = 0; k < 4; ++k) { v[k] = v[k] - mu; q += (v[k][0] * v[k][0] + v[k][1] * v[k][1]) + (v[k][2] * v[k][2] + v[k][3] * v[k][3]); }
        const float rs = rsqrtf(wave_sum(q) * (1.0f / D) + LN_EPS);
        u32x4 hw2[2];
#pragma unroll
        for (int j = 0; j < 2; ++j) {
            const f32x4 xo0 = v[2 * j] * rs * g[2 * j] + be[2 * j], xo1 = v[2 * j + 1] * rs * g[2 * j + 1] + be[2 * j + 1];
            u32x4 xw; xw.x = cvtpk(xo0[0], xo0[1]); xw.y = cvtpk(xo0[2], xo0[3]); xw.z = cvtpk(xo1[0], xo1[1]); xw.w = cvtpk(xo1[2], xo1[3]);
            *(u32x4*)(p.x1 + ro + 8 * lane + 512 * j) = xw;
            const f32x4 h0 = xo0 * (sc[2 * j] + 1.0f) + sh[2 * j], h1 = xo1 * (sc[2 * j + 1] + 1.0f) + sh[2 * j + 1];
            u32x4 w; w.x = cvtpk(h0[0], h0[1]); w.y = cvtpk(h0[2], h0[3]); w.z = cvtpk(h1[0], h1[1]); w.w = cvtpk(h1[2], h1[3]);
            *(u32x4*)(p.hbuf + tm_act(r0 + wid * 32 + i, 8 * lane + 512 * j)) = w;
            hw2[j] = w;
        }
        {
            float am = 0.f;
#pragma unroll
            for (int j = 0; j < 2; ++j)
#pragma unroll
                for (int q = 0; q < 4; ++q) am = fmaxf(am, fmaxf(fabsf(bflo(hw2[j][q])), fabsf(bfhi(hw2[j][q]))));
            am = wave_max(am);
            am = fmaxf(am, 1e-30f); const float inv = 119.0f / am;
#pragma unroll
            for (int j = 0; j < 2; ++j) {
                unsigned pa = 0u, pb = 0u;
#pragma unroll
                for (int q = 0; q < 4; ++q) {
                    const int x0 = (int)rintf(bflo(hw2[j][q]) * inv), x1 = (int)rintf(bfhi(hw2[j][q]) * inv);
                    const int b0 = ((x0 + 8) & 15) - 8, b1 = ((x1 + 8) & 15) - 8, a0 = (x0 - b0) >> 4, a1 = (x1 - b1) >> 4;
                    pa |= ((unsigned)a0 & 15u) << (8 * q); pa |= ((unsigned)a1 & 15u) << (8 * q + 4); pb |= ((unsigned)b0 & 15u) << (8 * q); pb |= ((unsigned)b1 & 15u) << (8 * q + 4);
                }
                unsigned* hp = p.hq + (size_t)(r0 + wid * 32 + i) * 256 + ((lane >> 2) + 16 * j) * 8 + (lane & 3);
                hp[0] = pa; hp[4] = pb;
            }
            if (lane == 0) p.hsc[r0 + wid * 32 + i] = am * (1.0f / 119.0f);
        }
      }
    }
    asm volatile("s_waitcnt vmcnt(0)" ::: "memory");
#undef LN_ISSUE
#undef LN_LD
}

__device__ __forceinline__ int f2ord(float v) { const int u = __float_as_int(v); return u ^ ((u >> 31) & 0x7fffffff); }
__device__ __forceinline__ float ord2f(int k) { return __int_as_float(k ^ ((k >> 31) & 0x7fffffff)); }
__device__ __forceinline__ void cex(int& a, int& b) { const int mx = max(a, b), mn = min(a, b); a = mx; b = mn; }
__device__ __forceinline__ void sort16_desc(int (&a)[16]) {
#pragma unroll
    for (int k = 2; k <= 16; k <<= 1)
#pragma unroll
        for (int j = k >> 1; j > 0; j >>= 1)
#pragma unroll
            for (int i = 0; i < 16; ++i) { const int l = i ^ j; if (l > i) { if ((i & k) == 0) cex(a[i], a[l]); else cex(a[l], a[i]); } }
}
__device__ __forceinline__ void merge16_desc(int (&a)[16]) {
#pragma unroll
    for (int j = 8; j > 0; j >>= 1)
#pragma unroll
        for (int i = 0; i < 16; ++i) { const int l = i ^ j; if (l > i) cex(a[i], a[l]); }
}
__device__ __forceinline__ void top16_merge(int (&top)[16], const int (&c)[16]) {
#pragma unroll
    for (int i = 0; i < 16; ++i) top[i] = max(top[i], c[15 - i]);
    merge16_desc(top);
}

struct EpiTopk {
    static constexpr bool PERM = false;
    int* hk; int hp0;
    __device__ __forceinline__ void operator()(f32x4 (&acc)[4][8], int mb, int nb, int lane, char* lds) {
        const int tid = opaque_tid(), wid = wave_of(tid), wm = wid >> 1, wn = wid & 1;
#pragma unroll 1
        for (int pass = 0; pass < 2; ++pass) {
            if (wn == pass) {
#pragma unroll
                for (int i = 0; i < 4; ++i) {
                    const int row = wm * 64 + i * 16 + (lane & 15);
#pragma unroll
                    for (int j = 0; j < 8; ++j) { const int c = j * 4 + (lane >> 4); *(f32x4*)(lds + row * 512 + ((c ^ (2 * (row & 7))) << 4)) = acc[i][j]; }
                }
            }
            __syncthreads();
            const int row = tid >> 1, half = tid & 1, sw = 2 * (row & 7);
            const char* rp = lds + row * 512;
            int top[16];
#pragma unroll
            for (int gq = 0; gq < 4; ++gq) {
                int c[16];
#pragma unroll
                for (int ii = 0; ii < 4; ++ii) {
                    const int ch = 2 * (4 * gq + ii) + half;
                    const f32x4 v = *(const f32x4*)(rp + ((ch ^ sw) << 4));
#pragma unroll
                    for (int e = 0; e < 4; ++e) c[4 * ii + e] = (f2ord(v[e]) & ~127) | (127 - (ch * 4 + e));
                }
                sort16_desc(c);
                if (gq == 0) {
#pragma unroll
                    for (int i = 0; i < 16; ++i) top[i] = c[i];
                } else top16_merge(top, c);
            }
            int oth[16];
#pragma unroll
            for (int i = 0; i < 16; ++i) oth[i] = __shfl_xor(top[15 - i], 1);
#pragma unroll
            for (int i = 0; i < 16; ++i) top[i] = max(top[i], oth[i]);
            merge16_desc(top);
            if (half == 0) {
                int* op = hk + ((size_t)(mb - wm * 64 + row) * 16 + hp0 + pass) * 16;
#pragma unroll
                for (int i = 0; i < 4; ++i) *(u32x4*)(op + 4 * i) = (u32x4){(unsigned)top[4 * i], (unsigned)top[4 * i + 1], (unsigned)top[4 * i + 2], (unsigned)top[4 * i + 3]};
            }
            __syncthreads();
        }
    }
};

__device__ __forceinline__ void route_combine(const Params& p, int r0) {
    const int tid = opaque_tid();
    for (int it = 0; it < 4; ++it) {
        const int th = it * 256 + tid, t = r0 + (th >> 3), h = th & 7;
        const int* ka = p.hk + ((size_t)t * 16 + 2 * h) * 16; const int* kb = ka + 16;
        float va[16], vb[16];
        int* lk = (int*)smem + tid * 33;
#pragma unroll
        for (int i = 0; i < 4; ++i) { const u32x4 a = *(const u32x4*)(ka + 4 * i), b = *(const u32x4*)(kb + 4 * i);
#pragma unroll
            for (int e = 0; e < 4; ++e) { va[4 * i + e] = ord2f((int)a[e] & ~127); vb[4 * i + e] = ord2f((int)b[e] & ~127);
                lk[4 * i + e] = (127 - ((int)a[e] & 127)) * 128; lk[16 + 4 * i + e] = 127 - ((int)b[e] & 127); } }
        int top[16];
        {
            int c[16];
#pragma unroll
            for (int j = 0; j < 16; ++j) c[j] = (f2ord(va[0] + vb[j]) & ~255) | (255 - j);
            sort16_desc(c);
#pragma unroll
            for (int i = 0; i < 16; ++i) top[i] = c[i];
#pragma unroll
            for (int j = 0; j < 8; ++j) c[j] = (f2ord(va[1] + vb[j]) & ~255) | (255 - (16 + j));
#pragma unroll
            for (int j = 0; j < 5; ++j) c[8 + j] = (f2ord(va[2] + vb[j]) & ~255) | (255 - (32 + j));
#pragma unroll
            for (int j = 0; j < 3; ++j) c[13 + j] = (f2ord(va[3] + vb[j]) & ~255) | (255 - (48 + j));
            sort16_desc(c); top16_merge(top, c);
            c[0] = (f2ord(va[3] + vb[3]) & ~255) | (255 - (48 + 3));
#pragma unroll
            for (int j = 0; j < 3; ++j) c[1 + j] = (f2ord(va[4] + vb[j]) & ~255) | (255 - (64 + j));
#pragma unroll
            for (int i = 5; i < 8; ++i)
#pragma unroll
                for (int j = 0; j < 2; ++j) c[4 + (i - 5) * 2 + j] = (f2ord(va[i] + vb[j]) & ~255) | (255 - (16 * i + j));
#pragma unroll
            for (int i = 8; i < 14; ++i) c[10 + (i - 8)] = (f2ord(va[i] + vb[0]) & ~255) | (255 - (16 * i));
            sort16_desc(c); top16_merge(top, c);
            c[0] = (f2ord(va[14] + vb[0]) & ~255) | (255 - 16 * 14); c[1] = (f2ord(va[15] + vb[0]) & ~255) | (255 - 16 * 15);
            cex(c[0], c[1]);
#pragma unroll
            for (int i = 2; i < 16; ++i) c[i] = (int)0x80000000;
            top16_merge(top, c);
        }
        float e[16], sum = 0.f; const float s0 = ord2f(top[0] & ~255);
#pragma unroll
        for (int k = 0; k < 16; ++k) { e[k] = __expf(ord2f(top[k] & ~255) - s0); sum += e[k]; }
        const float rs = 1.0f / sum;
        int* eo = p.eidx + (size_t)t * 128 + h * 16; float* go = p.gw + (size_t)t * 128 + h * 16;
#pragma unroll
        for (int k = 0; k < 16; ++k) { const int pos = 255 - (top[k] & 255); eo[k] = lk[pos >> 4] + lk[16 + (pos & 15)]; go[k] = e[k] * rs; }
    }
}

typedef __bf16 bf16x2_t __attribute__((ext_vector_type(2)));
__device__ __forceinline__ float dot2bf(unsigned a, unsigned b, float c) { return __builtin_amdgcn_fdot2_f32_bf16(__builtin_bit_cast(bf16x2_t, a), __builtin_bit_cast(bf16x2_t, b), c, false); }
__device__ __forceinline__ float gelu_erf(float s) { return 0.5f * s * (1.0f + erff(s * 0.70710678118654752f)); }

#define DPP_IADD(v, ctrl) ((v) + __builtin_amdgcn_update_dpp(0, (v), (ctrl), 0xf, 0xf, false))
__device__ __forceinline__ int wave_isum(int v) {
    v = DPP_IADD(v, 0xB1); v = DPP_IADD(v, 0x4E); v = DPP_IADD(v, 0x141); v = DPP_IADD(v, 0x140);
    { auto r = __builtin_amdgcn_permlane16_swap((unsigned)v, (unsigned)v, false, false); v = (int)(r[0] + r[1]); }
    { auto r = __builtin_amdgcn_permlane32_swap((unsigned)v, (unsigned)v, false, false); v = (int)(r[0] + r[1]); }
    return v;
}
__device__ __forceinline__ float ub0(unsigned w) { return (float)(w & 0xffu); }
__device__ __forceinline__ float ub1(unsigned w) { return (float)((w >> 8) & 0xffu); }
__device__ __forceinline__ float ub2(unsigned w) { return (float)((w >> 16) & 0xffu); }
__device__ __forceinline__ float ub3(unsigned w) { return (float)(w >> 24); }

constexpr int PEER_LVEC = 12288;
constexpr int PEER_LDS = PEER_LVEC + 4 * 16384;
__device__ __forceinline__ void peer_u(const Params& p, int t0, int ntok, int lane) {
    const int li = lane & 31, li16 = li * 16; const bool hi = lane >= 32;
    u32x4 buf[16]; unsigned mbuf[16];
#define PEV(esel, base, j) ({ const int ea__ = __builtin_amdgcn_readlane(esel, (base) + 2 * (j)), eb__ = __builtin_amdgcn_readlane(esel, (base) + 2 * (j) + 1); hi ? eb__ : ea__; })
#define PFU(j, esel, base) do { const int ev_ = PEV(esel, base, j); const int ro_ = ev_ * 512 + li16, mo_ = ev_ * 32 + li;        \
        asm volatile("global_load_dwordx4 %0, %1, %2" : "=v"(buf[j]) : "v"(ro_), "s"(p.u_q)); \
        asm volatile("global_load_ubyte %0, %1, %2" : "=v"(mbuf[j]) : "v"(mo_), "s"(p.u_m)); } while (0)
#define MBYTE(j) ({ asm volatile("s_waitcnt vmcnt(22)" : "+v"(mbuf[j])); mbuf[j]; })
#define DATA_R(j) ({ asm volatile("s_waitcnt vmcnt(22)" : "+v"(buf[j])); buf[j]; })
#define H_LOAD(tt) do { const u32x4 ha_ = *(const u32x4*)(p.hq + (size_t)(tt) * 256 + li * 8), hb_ = *(const u32x4*)(p.hq + (size_t)(tt) * 256 + li * 8 + 4); \
            _Pragma("unroll") for (int k = 0; k < 4; ++k) { hA[k] = ha_[k]; hB[k] = hb_[k]; } hs = p.hsc[(tt)]; } while (0)
    int e0 = p.eidx[(size_t)t0 * 128 + lane], e1 = p.eidx[(size_t)t0 * 128 + 64 + lane];
#pragma unroll
    for (int j = 0; j < 16; ++j) PFU(j, e0, 0);
    unsigned hA[4], hB[4]; float hs;
    H_LOAD(t0);
    asm volatile("s_waitcnt vmcnt(0)" ::: "memory");
#pragma unroll 1
    for (int it = 0; it < ntok; ++it) {
        const int t = t0 + it;
        const int tn = (it + 1 < ntok) ? t + 1 : t;
        const int e0n = p.eidx[(size_t)tn * 128 + lane], e1n = p.eidx[(size_t)tn * 128 + 64 + lane];
        if (it) H_LOAD(t);
        const float g0 = p.gw[(size_t)t * 128 + lane], g1 = p.gw[(size_t)t * 128 + 64 + lane], us0 = p.u_sc[e0], us1 = p.u_sc[e1], vs0 = p.v_sc[e0] * 255.0f, vs1 = p.v_sc[e1] * 255.0f;
        int sA = 0, sB = 0;
#define DPPM(v, ctrl) __builtin_amdgcn_update_dpp(0, (v), (ctrl), 0xf, 0xf, false)
#define PA_BLOCK(jb, DATA, PREFETCH) do { int sq_[4]; \
            _Pragma("unroll") for (int q = 0; q < 4; ++q) { const int j_ = 4 * (jb) + q; const u32x4 dd_ = DATA(j_); int sa2_ = 0, sb2_ = 0; \
                _Pragma("unroll") for (int k = 0; k < 4; ++k) { sa2_ = __builtin_amdgcn_sdot8((int)hA[k], (int)dd_[k], sa2_, false); sb2_ = __builtin_amdgcn_sdot8((int)hB[k], (int)dd_[k], sb2_, false); } \
                sq_[q] = __mul24((sa2_ << 4) + sb2_, (int)MBYTE(j_)); PREFETCH(j_); }       \
            const int r0_ = (b0_ ? sq_[2] : sq_[0]) + DPPM(b0_ ? sq_[0] : sq_[2], 0xB1), r1_ = (b0_ ? sq_[3] : sq_[1]) + DPPM(b0_ ? sq_[1] : sq_[3], 0xB1); \
            int u_ = (b1_ ? r1_ : r0_) + DPPM(b1_ ? r0_ : r1_, 0x4E);              \
            u_ += DPPM(u_, 0x124); u_ += DPPM(u_, 0x128);                         \
            { auto r_ = __builtin_amdgcn_permlane16_swap((unsigned)u_, (unsigned)u_, false, false); u_ = (int)(r_[0] + r_[1]); }     \
            { auto r_ = __builtin_amdgcn_permlane32_swap((unsigned)u_, (unsigned)u_, false, false); const int lo_ = (int)r_[0], hi_ = (int)r_[1];    \
                \
                \
              const int glA_ = DPPM(lo_, 0xF5), glB_ = DPPM(lo_, 0xA0), ghA_ = DPPM(hi_, 0xF5), ghB_ = DPPM(hi_, 0xA0); \
              const int gl_ = b2_ ? glA_ : glB_, gh_ = b2_ ? ghA_ : ghB_; \
              const int val_ = b0_ ? gh_ : gl_; sT = ((lrel >> 3) == (jb)) ? val_ : sT; } \
            __builtin_amdgcn_sched_barrier(0); } while (0)
        asm volatile(".p2align 6\n\ts_nop 0\n\ts_nop 0\n\ts_nop 0\n\ts_nop 0\n\ts_nop 0\n\ts_nop 0\n\ts_nop 0\n\ts_nop 0\n\ts_nop 0\n\ts_nop 0\n\ts_nop 0\n\ts_nop 0\n\ts_nop 0\n\ts_nop 0\n\ts_nop 0\n\ts_nop 0");
#pragma unroll 1
        for (int g = 0; g < 4; ++g) {
            int lane_ = lane; asm volatile("" : "+v"(lane_));
            int en_ = (g == 0) ? e0 : ((g == 3) ? e0n : e1); asm volatile("" : "+v"(en_));
            const int nb_ = (g & 1) ? 0 : 32;
            int sT = (g < 2) ? sA : sB;
            const bool b0_ = lane_ & 1, b1_ = lane_ & 2, b2_ = lane_ & 4;
            const int lrel = lane_ - 32 * (g & 1);
#define PF(j) PFU(j, en_, nb_)
#pragma unroll
            for (int jb = 0; jb < 4; ++jb) PA_BLOCK(jb, DATA_R, PF);
#undef PF
            if (g < 2) sA = sT; else sB = sT;
        }
#undef PA_BLOCK
#undef DPPM
        p.gw[(size_t)t * 128 + lane] = g0 * gelu_erf((float)sA * (hs * us0)) * vs0;
        p.gw[(size_t)t * 128 + 64 + lane] = g1 * gelu_erf((float)sB * (hs * us1)) * vs1;
        e0 = e0n; e1 = e1n;
    }
#undef PEV
#undef PFU
#undef MBYTE
#undef DATA_R
#undef H_LOAD
}

__device__ __forceinline__ void peer_v(const Params& p, int t0, int ntok, int lane, int wid, float* outbase, size_t tmask, const float* lvec  ) {
    const int li = lane & 31; const bool hi = lane >= 32;
    const int lring = PEER_LVEC + wid * 16384;
    int lx16[4];
#pragma unroll
    for (int s4 = 0; s4 < 4; ++s4) lx16[s4] = (li ^ (2 * s4 + (hi ? 1 : 0))) * 16;
#define ISSUE_V(s, esel, ln) do { const int ea__ = __builtin_amdgcn_readlane(esel, (ln)), eb__ = __builtin_amdgcn_readlane(esel, (ln) + 1); const int ev_ = hi ? eb__ : ea__; \
        const unsigned char* gp_ = p.v_q + (size_t)ev_ * 512 + lx16[(s) & 3]; \
        __builtin_amdgcn_global_load_lds((const unsigned*)gp_, (__attribute__((address_space(3))) unsigned*)(smem + lring + (s) * 1024), 16, 0, 0); } while (0)
    const int trr = (lane & 15) >> 1, trc = lane & 1, trg = lane >> 4;
    const unsigned tr_base = (unsigned)(size_t)(lds_cptr)(smem + lring + (trr >> 1) * 1024 + (trr & 1) * 512 + ((trg ^ (trr & 3)) << 4) + trc * 8);
    const unsigned trE = tr_base + ((trr >> 2) ? 64u : 0u), trO = tr_base - ((trr >> 2) ? 64u : 0u);
#define TRB8(dst, va, OFF) asm volatile("ds_read_b64_tr_b8 %0, %1 offset:%2" : "=v"(dst) : "v"(va), "n"(OFF) : "memory")
    int e0 = p.eidx[(size_t)t0 * 128 + lane], e1 = p.eidx[(size_t)t0 * 128 + 64 + lane];
    float wA = p.gw[(size_t)t0 * 128 + lane], wB = p.gw[(size_t)t0 * 128 + 64 + lane];
#pragma unroll
    for (int s = 0; s < 16; ++s) ISSUE_V(s, e0, 2 * s);
    asm volatile("s_waitcnt vmcnt(0)" ::: "memory");
#pragma unroll 1
    for (int it = 0; it < ntok; ++it) {
        const int t = t0 + it;
        const int tn = (it + 1 < ntok) ? t + 1 : t;
        const int e0n = p.eidx[(size_t)tn * 128 + lane], e1n = p.eidx[(size_t)tn * 128 + 64 + lane];
        const float wAn = p.gw[(size_t)tn * 128 + lane], wBn = p.gw[(size_t)tn * 128 + 64 + lane];
        float wmax = fmaxf(fabsf(wA), fabsf(wB));
#pragma unroll
        for (int o = 32; o > 0; o >>= 1) wmax = fmaxf(wmax, __shfl_xor(wmax, o));
        const float Sw = fmaxf(wmax * (1.0f / 127.0f), 1e-30f), invS = 1.0f / Sw;
        const int wqa = (int)rintf(wA * invS), wqb = (int)rintf(wB * invS);
        const int wqsum = wave_isum(wqa + wqb);
        int WpA = (wqa & 0xff) << (8 * (lane & 3)), WpB = (wqb & 0xff) << (8 * (lane & 3));
        WpA |= __builtin_amdgcn_update_dpp(0, WpA, 0xB1, 0xf, 0xf, false); WpA |= __builtin_amdgcn_update_dpp(0, WpA, 0x4E, 0xf, 0xf, false);
        WpB |= __builtin_amdgcn_update_dpp(0, WpB, 0xB1, 0xf, 0xf, false); WpB |= __builtin_amdgcn_update_dpp(0, WpB, 0x4E, 0xf, 0xf, false);
        int acci[16];
#pragma unroll
        for (int i = 0; i < 16; ++i) acci[i] = 0;
#define VB_BATCH(b) do { \
            asm volatile("s_waitcnt vmcnt(12)" ::: "memory"); \
            const int wl_ = 8 * ((4 * Bq + (b)) & 7); \
            const int W0_ = __builtin_amdgcn_readlane(wsel_, wl_), W1_ = __builtin_amdgcn_readlane(wsel_, wl_ + 4); \
            u32x2 d_[8]; \
            TRB8(d_[0], trE, (b) * 4096 + 0);   TRB8(d_[1], trO, (b) * 4096 + 64);  TRB8(d_[2], trE, (b) * 4096 + 128); TRB8(d_[3], trO, (b) * 4096 + 192); \
            TRB8(d_[4], trE, (b) * 4096 + 256); TRB8(d_[5], trO, (b) * 4096 + 320); TRB8(d_[6], trE, (b) * 4096 + 384); TRB8(d_[7], trO, (b) * 4096 + 448); \
            asm volatile("s_waitcnt lgkmcnt(0)" : "+v"(d_[0]), "+v"(d_[1]), "+v"(d_[2]), "+v"(d_[3]), "+v"(d_[4]), "+v"(d_[5]), "+v"(d_[6]), "+v"(d_[7])); \
            _Pragma("unroll") for (int s_ = 0; s_ < 4; ++s_) ISSUE_V(4 * (b) + s_, vsel_, vln_ + 2 * (4 * (b) + s_));        \
            _Pragma("unroll") for (int i = 0; i < 8; ++i) { \
                const unsigned lo0 = d_[i].x & 0x0F0F0F0Fu, hi0 = (d_[i].x >> 4) & 0x0F0F0F0Fu, lo1 = d_[i].y & 0x0F0F0F0Fu, hi1 = (d_[i].y >> 4) & 0x0F0F0F0Fu; \
                acci[2 * i] = __builtin_amdgcn_sdot4((int)lo0, W0_, acci[2 * i], false); acci[2 * i] = __builtin_amdgcn_sdot4((int)lo1, W1_, acci[2 * i], false); \
                acci[2 * i + 1] = __builtin_amdgcn_sdot4((int)hi0, W0_, acci[2 * i + 1], false); acci[2 * i + 1] = __builtin_amdgcn_sdot4((int)hi1, W1_, acci[2 * i + 1], false); } \
            __builtin_amdgcn_sched_barrier(0); } while (0)
#pragma unroll 1
        for (int Bq = 0; Bq < 4; ++Bq) {
            int wsel_ = (Bq < 2) ? WpA : WpB; int vsel_ = (Bq == 0) ? e0 : ((Bq == 3) ? e0n : e1); asm volatile("" : "+v"(wsel_), "+v"(vsel_));
            const int vln_ = ((Bq + 1) & 1) * 32;
            VB_BATCH(0); VB_BATCH(1); VB_BATCH(2); VB_BATCH(3);
        }
#undef VB_BATCH
        float* outp = outbase + ((size_t)t & tmask) * D;
        const int c0 = 32 * (lane >> 4) + 2 * (lane & 15);
        typedef float f32x2 __attribute__((ext_vector_type(2)));
        unsigned xw[8];
#pragma unroll
        for (int i = 0; i < 8; ++i) xw[i] = *(const unsigned*)(p.x1 + (size_t)t * D + c0 + 128 * i);
        float y[16]; float s = 0.f;
#pragma unroll
        for (int i = 0; i < 8; ++i) {
            const f32x2 g2 = *(const f32x2*)(lvec + c0 + 128 * i);
            const float f0 = (float)(acci[2 * i] - 8 * wqsum) * Sw, f1 = (float)(acci[2 * i + 1] - 8 * wqsum) * Sw;
            const float v0 = ALPHA * bflo(xw[i]) + g2[0] * f0, v1 = ALPHA * bfhi(xw[i]) + g2[1] * f1;
            y[2 * i] = v0; y[2 * i + 1] = v1; s += v0 + v1;
        }
        const float mu = wave_sum(s) * (1.0f / D);
        float q = 0.f;
#pragma unroll
        for (int i = 0; i < 16; ++i) { y[i] -= mu; q += y[i] * y[i]; }
        const float rsd = rsqrtf(wave_sum(q) * (1.0f / D) + LN_EPS);
#pragma unroll
        for (int i = 0; i < 8; ++i) {
            const f32x2 gg = *(const f32x2*)(lvec + 1024 + c0 + 128 * i), bb = *(const f32x2*)(lvec + 2048 + c0 + 128 * i);
            f32x2 o; o[0] = y[2 * i] * rsd * gg[0] + bb[0]; o[1] = y[2 * i + 1] * rsd * gg[1] + bb[1];
            *(f32x2*)(outp + c0 + 128 * i) = o;
        }
        e0 = e0n; e1 = e1n; wA = wAn; wB = wBn;
    }
#undef ISSUE_V
#undef TRB8
}


#define XB_TMO      128
#define XB_XCNT(j)  (256  + 64 * (j))
#define XB_XSUB(j)  (1280 + 64 * (j))
#define XB_XGEN(j)  (2304 + 64 * (j))
#define XB_TOP      3328
#define XB_TOPGEN   3392
#define XCD_BAR_WORDS 3456
#define XB_SPIN_CAP (1u << 20)
#define LAS __attribute__((address_space(3)))
__device__ __forceinline__ unsigned xb_ld(unsigned* p)              { return __hip_atomic_load(p, __ATOMIC_RELAXED, __HIP_MEMORY_SCOPE_AGENT); }
__device__ __forceinline__ unsigned xb_add(unsigned* p, unsigned v) { return __hip_atomic_fetch_add(p, v, __ATOMIC_RELAXED, __HIP_MEMORY_SCOPE_AGENT); }
__device__ __forceinline__ unsigned xb_xcc_id() { return (unsigned)__builtin_amdgcn_s_getreg((3 << 11) | 20) & 0xFu; }
#define XB_SPIN(cond, bar) do { unsigned _sp = 0; while (cond) { __builtin_amdgcn_s_sleep(1); \
    if ((++_sp & 255u) == 0u) { if (xb_ld(&(bar)[XB_TMO])) break; if (_sp > XB_SPIN_CAP) { atomicAdd(&(bar)[XB_TMO], 1u); break; } } } } while (0)
struct XcdBarrier { unsigned* bar; unsigned x; volatile LAS unsigned* st; };
__device__ __forceinline__ XcdBarrier xcd_barrier_post(unsigned* bar, volatile LAS unsigned* st) {
    XcdBarrier b; b.bar = bar; b.x = xb_xcc_id(); b.st = st;
    if (threadIdx.x == 0) (void)xb_add(&bar[XB_XCNT(b.x)], 1u);
    return b;
}
__device__ __forceinline__ void xcd_barrier_complete(unsigned* bar, unsigned x, unsigned& nloc, unsigned& nx) {
    const unsigned G = gridDim.x * gridDim.y * gridDim.z;
    unsigned sum, cnt, mine, sp = 0u;
    for (;;) {
        sum = 0u; cnt = 0u; mine = 0u;
#pragma unroll
        for (unsigned j = 0; j < 16; ++j) { const unsigned c = xb_ld(&bar[XB_XCNT(j)]); sum += c; cnt += (c > 0u) ? 1u : 0u; mine = (j == x) ? c : mine; }
        if (sum == G) break;
        __builtin_amdgcn_s_sleep(1);
        if ((++sp & 255u) == 0u) { if (xb_ld(&bar[XB_TMO])) break; if (sp > XB_SPIN_CAP) { atomicAdd(&bar[XB_TMO], 1u); break; } }
    }
    nloc = mine > 0u ? mine : 1u; nx = cnt > 0u ? cnt : 1u;
}
__device__ __forceinline__ void xcd_barrier(const XcdBarrier& b) {
    asm volatile("s_waitcnt vmcnt(0)" ::: "memory");
    __syncthreads();
    if (threadIdx.x == 0) {
        unsigned* bar = b.bar;
        __builtin_amdgcn_s_waitcnt(0);
        unsigned nloc = b.st[0], nx = b.st[1];
        if (nloc == 0u) { xcd_barrier_complete(bar, b.x, nloc, nx); b.st[0] = nloc; b.st[1] = nx; }
        const unsigned old = xb_add(&bar[XB_XSUB(b.x)], 1u);
        const unsigned gen = old / nloc;
        if (old + 1u == (gen + 1u) * nloc) {
            __builtin_amdgcn_fence(__ATOMIC_RELEASE, "agent");
            asm volatile("s_waitcnt vmcnt(0)" ::: "memory");
            const unsigned og = xb_add(&bar[XB_TOP], 1u);
            const unsigned tg = og / nx;
            if (og + 1u == (tg + 1u) * nx) xb_add(&bar[XB_TOPGEN], 1u);
            else XB_SPIN(xb_ld(&bar[XB_TOPGEN]) == tg, bar);
            __builtin_amdgcn_fence(__ATOMIC_ACQUIRE, "agent");
            xb_add(&bar[XB_XGEN(b.x)], 1u);
            asm volatile("s_waitcnt vmcnt(0)" ::: "memory");
        } else {
            XB_SPIN(xb_ld(&bar[XB_XGEN(b.x)]) == gen, bar);
            __builtin_amdgcn_fence(__ATOMIC_ACQUIRE, "agent");
            asm volatile("s_waitcnt vmcnt(0)" ::: "memory");
        }
    }
    __syncthreads();
}

constexpr int MEGA_LDS0 = ATT_LDS > GEMM_LDS ? ATT_LDS : GEMM_LDS;
constexpr int MEGA_LDS = MEGA_LDS0 > PEER_LDS ? MEGA_LDS0 : PEER_LDS;
__global__ __launch_bounds__(256, 2) void mega_fwd(Params p) {
    cooperative_groups::grid_group grid = cooperative_groups::this_grid();
    const int nblk = gridDim.x, bid = blockIdx.x;
    volatile LAS unsigned* xst = (volatile LAS unsigned*)(smem + MEGA_LDS);
    if (threadIdx.x == 0) { xst[0] = 0u; xst[1] = 0u; }
    __syncthreads();
    const XcdBarrier xb = xcd_barrier_post(p.bar, xst);
    for (int it = bid; it < PREP_MOD; it += nblk) mod_item(p, it);
    if (__builtin_expect(p.out == nullptr, 0)) grid.sync();
    xcd_barrier(xb);
    if ((bid >> 3) & 1) {
        for (int it = bid; it < PREP_REST; it += nblk) prep_item(p, it);
        for (int mt = bid; mt < T / 128; mt += nblk) modulate_rows(p.x, p.mod, SH1, SC1, p.hbuf, mt * 128, 128);
    } else {
        for (int mt = bid; mt < T / 128; mt += nblk) modulate_rows(p.x, p.mod, SH1, SC1, p.hbuf, mt * 128, 128);
        for (int it = bid; it < PREP_REST; it += nblk) prep_item(p, it);
    }
    xcd_barrier(xb);
    {
        const int x = bid & 7, rank = bid >> 3, per = nblk >> 3;
        EpiProj epi{p.proj};
        for (int mt = rank; mt < T / 128; mt += per) gemm_tile(p.hbuf, p.w_in_t, INW, mt * 128, x * 256, smem, epi);
        for (int mt = bid; mt < T / 128; mt += nblk) gemm_tile(p.hbuf, p.w_in_t, INW, mt * 128, 8 * 256, smem, epi);
    }
    xcd_barrier(xb);
    {
        const float lam = p.scal[0];
        const int xcd = bid & 7, rank = bid >> 3, per = nblk >> 3;
        for (int r0 = 0; r0 < ATT_ITEMS; r0 += nblk) { const int item = r0 + xcd * per + rank; if (item < ATT_ITEMS) attn_item(p, item, lam); }
    }
    xcd_barrier(xb);
    for (int mt = bid; mt < T / 128; mt += nblk) {
        { EpiY1 epi{p.x, p.mod, p.y1};
          for (int nt = 0; nt < D / 256; ++nt) gemm_tile(p.attn, p.w_out_t, D, mt * 128, nt * 256, smem, epi); }
        __syncthreads();
        ln1_rows(p, mt * 128);
        __syncthreads();
        for (int nt = 0; nt < 8; ++nt) { EpiTopk epi{p.hk, 2 * nt}; gemm_tile(p.hbuf, p.weff_t, 2048, mt * 128, nt * 256, smem, epi); }
        __syncthreads();
        route_combine(p, mt * 128);
        __syncthreads();
        const int ptid = opaque_tid(), lane = ptid & 63, wid = wave_of(ptid);
        peer_u(p, mt * 128 + wid * 32, 32, lane);
        __syncthreads();
    }
    xcd_barrier(xb);
    for (int mt = bid; mt < T / 128; mt += nblk) {
        const int ptid = opaque_tid(), lane = ptid & 63, wid = wave_of(ptid);
        {
            float* lv = (float*)smem; const int bb = (mt * 128) / S;
            *(f32x4*)(lv + ptid * 4) = *(const f32x4*)(p.mod + bb * MODW + G2 + ptid * 4);
            *(f32x4*)(lv + 1024 + ptid * 4) = *(const f32x4*)(p.ln2_g + ptid * 4);
            *(f32x4*)(lv + 2048 + ptid * 4) = *(const f32x4*)(p.ln2_b + ptid * 4);
            __syncthreads();
        }
        peer_v(p, mt * 128 + wid * 32, 32, lane, wid, p.out, ~(size_t)0, (const float*)smem);
        __syncthreads();
    }
}
}

extern "C" void kernel_launch(void* const* d_in, const int* in_sizes, int n_in, void* d_out, int out_size, void* d_ws, size_t ws_size, hipStream_t stream) {
    Params p{};
    p.x = (const float*)d_in[0]; p.c = (const float*)d_in[1]; p.w_ada = (const float*)d_in[2]; p.b_ada = (const float*)d_in[3];
    p.w_in = (const float*)d_in[4]; p.lq1 = (const float*)d_in[5]; p.lk1 = (const float*)d_in[6]; p.lq2 = (const float*)d_in[7]; p.lk2 = (const float*)d_in[8];
    p.subln_g = (const float*)d_in[9]; p.sinks = (const float*)d_in[10]; p.w_out = (const float*)d_in[11]; p.ln1_g = (const float*)d_in[12]; p.ln1_b = (const float*)d_in[13];
    p.w_pq = (const float*)d_in[14]; p.sub_keys = (const float*)d_in[15]; p.u_tab = (const float*)d_in[16]; p.v_tab = (const float*)d_in[17];
    p.ln2_g = (const float*)d_in[18]; p.ln2_b = (const float*)d_in[19];
    p.out = (float*)d_out;
    char* ws = (char*)d_ws; const size_t MiB = 1ull << 20;
    p.mod = (float*)(ws);
    p.bar = (unsigned*)(ws + 768 * 1024);
    p.scal = (float*)(ws + 768 * 1024 + 16384);
    p.w_in_t = (bf16_t*)(ws + 1 * MiB);
    p.w_out_t = (bf16_t*)(ws + 6 * MiB);
    p.weff_t = (bf16_t*)(ws + 8 * MiB);
    p.u_q = (unsigned char*)(ws + 12 * MiB);
    p.v_q = (unsigned char*)(ws + 28 * MiB);
    p.u_sc = (float*)(ws + 44 * MiB);
    p.v_sc = (float*)(ws + 44 * MiB + 65536);
    p.v_m = (unsigned char*)(ws + 45 * MiB);
    p.u_m = (unsigned char*)(ws + 46 * MiB);
    p.hbuf = (bf16_t*)(ws + 76 * MiB);
    p.proj = (bf16_t*)(ws + 204 * MiB);
    p.attn = (bf16_t*)(ws + 492 * MiB);
    p.x1 = p.attn;
    p.y1 = (bf16_t*)(ws + 332 * MiB);
    p.hq = (unsigned*)(ws + 620 * MiB);
    p.hsc = (float*)(ws + 684 * MiB);
    p.hk = (int*)(ws + 204 * MiB);
    p.eidx = (int*)(ws + 268 * MiB);
    p.gw = (float*)(ws + 300 * MiB);

    static int grid_blocks = 0;
    if (!grid_blocks) {
        int dev = 0, cus = 0, per_cu = 0;
        (void)hipGetDevice(&dev);
        (void)hipDeviceGetAttribute(&cus, hipDeviceAttributeMultiprocessorCount, dev);
        (void)hipFuncSetAttribute((const void*)mega_fwd, hipFuncAttributeMaxDynamicSharedMemorySize, MEGA_LDS + 16);
        (void)hipOccupancyMaxActiveBlocksPerMultiprocessor(&per_cu, mega_fwd, 256, MEGA_LDS + 16);
        if (per_cu > 2) per_cu = 2;
        grid_blocks = cus * per_cu;
        grid_blocks -= grid_blocks % 8;
    }
    (void)hipMemsetAsync(p.bar, 0, XCD_BAR_WORDS * sizeof(unsigned), stream);
    void* args[] = {&p};
    hipError_t e = hipLaunchCooperativeKernel((const void*)mega_fwd, dim3(grid_blocks), dim3(256), args, MEGA_LDS + 16, stream);
    if (e != hipSuccess) fprintf(stderr, "cooperative launch failed: %s (grid %d)\n", hipGetErrorString(e), grid_blocks);
}
```

```cpp
#include <hip/hip_runtime.h>
#include <hip/hip_cooperative_groups.h>
#include <stdint.h>
#include <cstdio>

namespace {
typedef unsigned short bf16_t;
typedef short bf16x8 __attribute__((ext_vector_type(8)));
typedef short s16x4 __attribute__((ext_vector_type(4)));
typedef float f32x4 __attribute__((ext_vector_type(4)));
typedef float f32x16 __attribute__((ext_vector_type(16)));
typedef unsigned u32x4 __attribute__((ext_vector_type(4)));
typedef unsigned u32x2 __attribute__((ext_vector_type(2)));
constexpr float LOG2E = 1.4426950408889634f;
constexpr float QSCALE = 0.125f * LOG2E;
typedef __bf16 bf16pair_t __attribute__((ext_vector_type(2)));
__device__ __forceinline__ unsigned cvtpk(float lo, float hi) { bf16pair_t v; v[0] = (__bf16)lo; v[1] = (__bf16)hi; return __builtin_bit_cast(unsigned, v); }
__device__ __forceinline__ int opaque_tid() { int t = threadIdx.x; asm volatile("" : "+v"(t)); return t; }
__device__ __forceinline__ int wave_of(int tid) { return __builtin_amdgcn_readfirstlane(tid >> 6); }
__device__ __forceinline__ float bf2f(bf16_t b) { return __uint_as_float((unsigned)b << 16); }
__device__ __forceinline__ float bflo(unsigned w) { return __uint_as_float(w << 16); }
__device__ __forceinline__ float bfhi(unsigned w) { return __uint_as_float(w & 0xffff0000u); }

constexpr int D = 1024, NB = 32, S = 2048, T = NB * S;
constexpr int INW = 2304, MODW = 6144;
constexpr float LN_EPS = 1e-5f;
constexpr float ALPHA = 1.189207115002721f;
constexpr float LAMBDA_INIT = 0.2f;
constexpr int SH1 = 0, SC1 = 1024, G1 = 2048, SH2 = 3072, SC2 = 4096, G2 = 5120;
__device__ __forceinline__ size_t tm_act(int r, int k) { return (size_t)(r >> 7) * 131072 + (size_t)((k >> 5) * 4096 + (r & 127) * 32 + (k & 31)); }
__device__ __forceinline__ size_t tm_w(int n, int k, int N) { return ((size_t)(k >> 5) * N + n) * 32 + (k & 31); }


struct Params {
    const float *x, *c, *w_ada, *b_ada, *w_in, *lq1, *lk1, *lq2, *lk2, *subln_g, *sinks, *w_out, *ln1_g, *ln1_b, *w_pq, *sub_keys, *u_tab, *v_tab, *ln2_g, *ln2_b;
    float* out;
    float* mod;
    bf16_t* w_in_t;
    bf16_t* w_out_t;
    bf16_t* weff_t;
    unsigned char* u_q;
    unsigned char* v_q;
    float* u_sc;
    unsigned char* u_m;
    unsigned char* v_m;
    float* v_sc;
    bf16_t* hbuf;
    bf16_t* proj;
    bf16_t* attn;
    bf16_t* y1;
    unsigned* hq;
    float* hsc;
    bf16_t* x1;
    int* hk;
    int* eidx;
    float* gw;
    unsigned* bar;
    float* scal;
};

extern __shared__ __attribute__((aligned(16))) char smem[];

constexpr int PREP_MOD = 384;
constexpr int PREP_TIN = 16 * 36;
constexpr int PREP_TOUT = 16 * 16;
constexpr int PREP_WEFF = 16 * 2 * 32;
constexpr int PREP_CVT = 512;
constexpr int PREP_REST = PREP_TIN + PREP_TOUT + PREP_WEFF + 2 * PREP_CVT;

__device__ __forceinline__ void tr_tile(const float* __restrict__ src, int N, int K, bf16_t* __restrict__ dst, int kt, int nt, float* lds) {
    const int tid = opaque_tid();
#pragma unroll
    for (int i = 0; i < 16; ++i) { const int idx = tid + i * 256, r = idx >> 6, cc = idx & 63; lds[r * 65 + cc] = src[(size_t)(kt * 64 + r) * N + nt * 64 + cc]; }
    __syncthreads();
#pragma unroll
    for (int i = 0; i < 16; ++i) { const int idx = tid + i * 256, n = idx >> 6, k = idx & 63; dst[tm_w(nt * 64 + n, kt * 64 + k, N)] = (bf16_t)(cvtpk(lds[k * 65 + n], 0.f) & 0xffffu); }
    __syncthreads();
}

__device__ __forceinline__ void mod_item(const Params& p, int item) {
    const int tid = opaque_tid(), lane = tid & 63, wid = wave_of(tid);
    float* lds = (float*)smem;
    const int cb = item >> 2, bg = item & 3, j = cb * 64 + lane;
    for (int i = tid; i < 8192; i += 256) { const int b = i >> 10, k = i & 1023; const float v = p.c[(bg * 8 + b) * D + k]; lds[k * 8 + b] = v / (1.0f + expf(-v)); }
    __syncthreads();
    float acc[8];
#pragma unroll
    for (int b = 0; b < 8; ++b) acc[b] = 0.f;
    const float* wp = p.w_ada + (size_t)(wid * 256) * MODW + j;
#pragma unroll 4
    for (int k = 0; k < 256; ++k) {
        const float wv = wp[(size_t)k * MODW];
        const f32x4 s0 = *(const f32x4*)(lds + (wid * 256 + k) * 8), s1 = *(const f32x4*)(lds + (wid * 256 + k) * 8 + 4);
        acc[0] += s0[0] * wv; acc[1] += s0[1] * wv; acc[2] += s0[2] * wv; acc[3] += s0[3] * wv;
        acc[4] += s1[0] * wv; acc[5] += s1[1] * wv; acc[6] += s1[2] * wv; acc[7] += s1[3] * wv;
    }
    float* red = lds + 8192;
#pragma unroll
    for (int b = 0; b < 8; ++b) red[(wid * 8 + b) * 64 + lane] = acc[b];
    __syncthreads();
#pragma unroll
    for (int r = 0; r < 2; ++r) {
        const int o = tid + 256 * r, b = o >> 6, col = o & 63;
        const float s = (red[(0 * 8 + b) * 64 + col] + red[(1 * 8 + b) * 64 + col]) + (red[(2 * 8 + b) * 64 + col] + red[(3 * 8 + b) * 64 + col]);
        p.mod[(bg * 8 + b) * MODW + cb * 64 + col] = s + p.b_ada[cb * 64 + col];
    }
    if (item == 0 && tid == 0) {
        float s1 = 0.f, s2 = 0.f;
        for (int i = 0; i < 64; ++i) { s1 += p.lq1[i] * p.lk1[i]; s2 += p.lq2[i] * p.lk2[i]; }
        p.scal[0] = expf(s1) - expf(s2) + LAMBDA_INIT;
    }
    __syncthreads();
}

__device__ __forceinline__ void prep_item(const Params& p, int item) {
    const int tid = opaque_tid();
    float* lds = (float*)smem;
    if (item < PREP_TIN) { tr_tile(p.w_in, INW, D, p.w_in_t, item / 36, item % 36, lds); return; }
    item -= PREP_TIN;
    if (item < PREP_TOUT) { tr_tile(p.w_out, D, D, p.w_out_t, item / 16, item % 16, lds); return; }
    item -= PREP_TOUT;
    if (item < PREP_WEFF) {
        const int hp = item >> 6, nh = (item >> 5) & 1, ct = item & 31;
        float* ks = lds;
        float* wsm = lds + 64 * 129;
        for (int i = tid; i < 64 * 128; i += 256) { const int n = i >> 7, d = i & 127; ks[n * 129 + d] = p.sub_keys[((size_t)hp * 128 + nh * 64 + n) * 128 + d]; }
        for (int i = tid; i < 32 * 128; i += 256) { const int cc = i >> 7, d = i & 127; wsm[cc * 128 + d] = p.w_pq[(size_t)(ct * 32 + cc) * 2048 + hp * 128 + d]; }
        __syncthreads();
        const int n = tid & 63, cb = (tid >> 6) * 8;
        float acc[8];
#pragma unroll
        for (int cc = 0; cc < 8; ++cc) acc[cc] = 0.f;
        for (int d = 0; d < 128; ++d) { const float kv = ks[n * 129 + d];
#pragma unroll
            for (int cc = 0; cc < 8; ++cc) acc[cc] += kv * wsm[(cb + cc) * 128 + d]; }
        u32x4 w; w.x = cvtpk(acc[0], acc[1]); w.y = cvtpk(acc[2], acc[3]); w.z = cvtpk(acc[4], acc[5]); w.w = cvtpk(acc[6], acc[7]);
        *(u32x4*)(p.weff_t + tm_w(hp * 128 + nh * 64 + n, ct * 32 + cb, 2048)) = w;
        __syncthreads();
        return;
    }
    item -= PREP_WEFF;
    {
        const bool isv = item >= PREP_CVT;
        const float* src = isv ? p.v_tab : p.u_tab; unsigned char* dst = isv ? p.v_q : p.u_q; unsigned char* mdst = isv ? p.v_m : p.u_m; float* scl = isv ? p.v_sc : p.u_sc;
        const int lane = tid & 63, wid = wave_of(tid);
        for (int i0 = 0; i0 < 8; i0 += 4) {
            f32x4 vv[4][4];
#pragma unroll
            for (int r = 0; r < 4; ++r) { const float* rp = src + (size_t)((item % PREP_CVT) * 32 + wid * 8 + i0 + r) * D + lane * 16;
#pragma unroll
                for (int j = 0; j < 4; ++j) vv[r][j] = *(const f32x4*)(rp + 4 * j); }
#pragma unroll
            for (int r = 0; r < 4; ++r) {
                const int e = (item % PREP_CVT) * 32 + wid * 8 + i0 + r;
                float gm = 0.f;
#pragma unroll
                for (int j = 0; j < 4; ++j) gm = fmaxf(gm, fmaxf(fmaxf(fabsf(vv[r][j][0]), fabsf(vv[r][j][1])), fmaxf(fabsf(vv[r][j][2]), fabsf(vv[r][j][3]))));
                float am = gm;
#pragma unroll
                for (int o = 32; o > 0; o >>= 1) am = fmaxf(am, __shfl_xor(am, o));
                am = fmaxf(am, 1e-30f);
                gm = fmaxf(gm, __shfl_xor(gm, 1));
                int mq = (int)ceilf(gm * 255.0f / am); mq = mq < 1 ? 1 : (mq > 255 ? 255 : mq); if (isv) mq = 255;
                const float gi = 7.0f * 255.0f / (am * (float)mq);
                unsigned w0 = 0u, w1 = 0u;
#pragma unroll
                for (int j = 0; j < 4; ++j)
#pragma unroll
                    for (int q = 0; q < 4; ++q) {
                        int n = (int)rintf(vv[r][j][q] * gi); n = n < -7 ? -7 : (n > 7 ? 7 : n); n = isv ? n + 8 : (n & 15);
                        const int idx = 4 * j + q;
                        if (idx < 8) w0 |= (unsigned)n << (4 * idx); else w1 |= (unsigned)n << (4 * (idx - 8));
                    }
                u32x2 ww; ww.x = w0; ww.y = w1;
                *(u32x2*)(dst + (size_t)e * 512 + lane * 8) = ww;
                if ((lane & 1) == 0) mdst[(size_t)e * 32 + (lane >> 1)] = (unsigned char)mq;
                if (lane == 0) scl[e] = am * (1.0f / (255.0f * 7.0f));
            }
        }
    }
}

__device__ __forceinline__ void modulate_rows(const float* __restrict__ x, const float* __restrict__ mod, int sh_off, int sc_off, bf16_t* __restrict__ h, int r0, int nrows) {
    const int tid = opaque_tid();
    for (int i = tid; i < nrows * 128; i += 256) {
        const int r = r0 + (i >> 7), k = (i & 127) * 8, b = r / S;
        const float* xp = x + (size_t)r * D + k; const float* sc = mod + b * MODW + sc_off + k; const float* sh = mod + b * MODW + sh_off + k;
        const float4 x0 = *(const float4*)xp, x1v = *(const float4*)(xp + 4), c0 = *(const float4*)sc, c1 = *(const float4*)(sc + 4), s0 = *(const float4*)sh, s1 = *(const float4*)(sh + 4);
        u32x4 w;
        w.x = cvtpk(x0.x * (1.f + c0.x) + s0.x, x0.y * (1.f + c0.y) + s0.y); w.y = cvtpk(x0.z * (1.f + c0.z) + s0.z, x0.w * (1.f + c0.w) + s0.w);
        w.z = cvtpk(x1v.x * (1.f + c1.x) + s1.x, x1v.y * (1.f + c1.y) + s1.y); w.w = cvtpk(x1v.z * (1.f + c1.z) + s1.z, x1v.w * (1.f + c1.w) + s1.w);
        *(u32x4*)(h + tm_act(r, k)) = w;
    }
}

constexpr int GEMM_STAGE = 24576;
constexpr int GEMM_LDS = 3 * GEMM_STAGE;
constexpr int GK = 1024;
#define GLDS16(gp, off) __builtin_amdgcn_global_load_lds((const unsigned*)(gp), (__attribute__((address_space(3))) unsigned*)(smem + (off)), 16, 0, 0)
template <class Epi>
__device__ __forceinline__ void gemm_tile(const bf16_t* __restrict__ A, const bf16_t* __restrict__ Bt, int BN, int m0, int n0, char* lds, Epi& epi) {
    const int tid = opaque_tid(), lane = tid & 63, wid = wave_of(tid), wm = wid >> 1, wn = wid & 1;
    const int swz = (((lane & 3) ^ ((0 - (lane >> 4)) & 3)) * 8), r16 = lane >> 2;
    const int goff = r16 * 32 + swz;
    const int goffB = Epi::PERM ? (8 * (r16 >> 2) + (r16 & 3)) * 32 + swz : goff;
    constexpr int BQ1 = Epi::PERM ? 4 * 32 : 16 * 32, BQ2 = 32 * 32, BQ3 = Epi::PERM ? 36 * 32 : 48 * 32;
    const bf16_t* Ab = A + (size_t)m0 * GK + wid * 1024 + goff; const bf16_t* Bb = Bt + (size_t)(n0 + wid * 64) * 32 + goffB;
    const int bks = BN * 32;
    const int dstA = wid * 2048, dstB = 8192 + wid * 4096;
    const int fsw = (((lane >> 4) ^ (0 - ((lane & 15) >> 2))) & 3) * 16;
    const int fa = (wm * 64 + (lane & 15)) * 64 + fsw, fb = 8192 + (wn * 128 + (lane & 15)) * 64 + fsw;
    f32x4 acc[4][8];
#pragma unroll
    for (int i = 0; i < 4; ++i)
#pragma unroll
        for (int j = 0; j < 8; ++j) acc[i][j] = (f32x4){0.f, 0.f, 0.f, 0.f};
    constexpr int nk = GK / 32;
#define GEMM_STAGE_LOAD(kt, st) do { const int so_ = (st) * GEMM_STAGE; \
        GLDS16(Ab + (kt) * 4096, so_ + dstA); GLDS16(Ab + (kt) * 4096 + 512, so_ + dstA + 1024); const bf16_t* bq_ = Bb + (size_t)(kt) * bks; \
        GLDS16(bq_, so_ + dstB); GLDS16(bq_ + BQ1, so_ + dstB + 1024); GLDS16(bq_ + BQ2, so_ + dstB + 2048); GLDS16(bq_ + BQ3, so_ + dstB + 3072); } while (0)
    GEMM_STAGE_LOAD(0, 0);
    GEMM_STAGE_LOAD(1, 1);
    int cur = 0, nx2 = 2 * GEMM_STAGE;
#pragma unroll 1
    for (int kt = 0; kt < nk; ++kt) {
        if (kt + 1 < nk) asm volatile("s_waitcnt vmcnt(6)" ::: "memory"); else asm volatile("s_waitcnt vmcnt(0)" ::: "memory");
        __builtin_amdgcn_s_barrier();
        asm volatile("" ::: "memory");
        bf16x8 af[4], bfr[8];
#pragma unroll
        for (int i = 0; i < 4; ++i) af[i] = *(const bf16x8*)(lds + cur + fa + i * 1024);
#pragma unroll
        for (int j = 0; j < 8; ++j) bfr[j] = *(const bf16x8*)(lds + cur + fb + j * 1024);
        __builtin_amdgcn_sched_barrier(0);
        if (kt + 2 < nk) { const int so_ = nx2;
            GLDS16(Ab + (kt + 2) * 4096, so_ + dstA); GLDS16(Ab + (kt + 2) * 4096 + 512, so_ + dstA + 1024); const bf16_t* bq_ = Bb + (size_t)(kt + 2) * bks;
            GLDS16(bq_, so_ + dstB); GLDS16(bq_ + BQ1, so_ + dstB + 1024); GLDS16(bq_ + BQ2, so_ + dstB + 2048); GLDS16(bq_ + BQ3, so_ + dstB + 3072); }
        __builtin_amdgcn_sched_barrier(0);
#pragma unroll
        for (int j = 0; j < 8; ++j)
#pragma unroll
            for (int i = 0; i < 4; ++i) acc[i][j] = __builtin_amdgcn_mfma_f32_16x16x32_bf16(bfr[j], af[i], acc[i][j], 0, 0, 0);
        nx2 = cur; cur = (cur == 2 * GEMM_STAGE) ? 0 : cur + GEMM_STAGE;
    }
    __syncthreads();
#undef GEMM_STAGE_LOAD
    epi(acc, m0 + wm * 64, n0 + wn * 128, lane, lds);
}

struct EpiProj {
    static constexpr bool PERM = true;
    bf16_t* out;
    __device__ __forceinline__ void operator()(f32x4 (&acc)[4][8], int mb, int nb, int lane, char*) {
#pragma unroll
        for (int g = 0; g < 4; ++g) {
            const int col = nb + g * 32 + (lane >> 4) * 8;
            const float sc = (col < 512 || (col >= 1536 && col < 2048)) ? QSCALE : 1.0f;
#pragma unroll
            for (int i = 0; i < 4; ++i) {
                const int row = mb + i * 16 + (lane & 15);
                const f32x4 a = acc[i][2 * g], c = acc[i][2 * g + 1];
                u32x4 w; w.x = cvtpk(a[0] * sc, a[1] * sc); w.y = cvtpk(a[2] * sc, a[3] * sc); w.z = cvtpk(c[0] * sc, c[1] * sc); w.w = cvtpk(c[2] * sc, c[3] * sc);
                *(u32x4*)(out + (size_t)row * INW + col) = w;
            }
        }
    }
};


constexpr int ATT_WS = 69632;
constexpr int ATT_LDS = ATT_WS + 4 * 256;
#define MFMA32(a, b, c) __builtin_amdgcn_mfma_f32_32x32x16_bf16(a, b, c, 0, 0, 0)
typedef short v4i16_t __attribute__((ext_vector_type(4)));
typedef __attribute__((address_space(3))) const char* lds_cptr;
__device__ __forceinline__ s16x4 vtr(const char* p) { return __builtin_bit_cast(s16x4, __builtin_amdgcn_ds_read_tr16_b64_v4i16((__attribute__((address_space(3))) v4i16_t*)(lds_cptr)p)); }
__device__ __forceinline__ int crow(int r, int hi) { return (r & 3) + 8 * (r >> 2) + 4 * hi; }
__device__ __forceinline__ float max3f(float a, float b, float c) { float r; asm("v_max3_f32 %0, %1, %2, %3" : "=v"(r) : "v"(a), "v"(b), "v"(c)); return r; }
__device__ __forceinline__ float rowmax32(const f32x16& p0, const f32x16& p1) {
    float x0 = p0[0], x1 = p1[0]; asm volatile("s_nop 7\n\ts_nop 3" : "+v"(x0), "+v"(x1));
    float a = max3f(x0, p0[1], p0[2]), b = max3f(x1, p1[1], p1[2]);
#pragma unroll
    for (int r = 3; r < 15; r += 2) { a = max3f(a, p0[r], p0[r + 1]); b = max3f(b, p1[r], p1[r + 1]); }
    a = max3f(a, p0[15], b); a = fmaxf(a, p1[15]);
    auto rr = __builtin_amdgcn_permlane32_swap(__float_as_uint(a), __float_as_uint(a), false, false);
    return fmaxf(__uint_as_float(rr[0]), __uint_as_float(rr[1]));
}

struct VFrag { u32x2 lo, hh; };
#define VTR1(dst, va, OFF) asm volatile("ds_read_b64_tr_b16 %0, %1 offset:%2" : "=v"(dst) : "v"(va), "n"(OFF) : "memory")
template <int DV, int KS>
__device__ __forceinline__ void vload(VFrag (&f)[DV / 32], unsigned va) {
    constexpr int KBS = (DV / 32) * 512;
    VTR1(f[0].lo, va, (2 * KS) * KBS); VTR1(f[0].hh, va, (2 * KS + 1) * KBS);
    VTR1(f[1].lo, va, (2 * KS) * KBS + 512); VTR1(f[1].hh, va, (2 * KS + 1) * KBS + 512);
    if constexpr (DV == 128) {
        VTR1(f[2].lo, va, (2 * KS) * KBS + 1024); VTR1(f[2].hh, va, (2 * KS + 1) * KBS + 1024);
        VTR1(f[3].lo, va, (2 * KS) * KBS + 1536); VTR1(f[3].hh, va, (2 * KS + 1) * KBS + 1536);
    }
}
template <int DV, int N>
__device__ __forceinline__ void vwait(VFrag (&f)[DV / 32]) {
    if constexpr (DV == 128) asm volatile("s_waitcnt lgkmcnt(%8)" : "+v"(f[0].lo), "+v"(f[0].hh), "+v"(f[1].lo), "+v"(f[1].hh), "+v"(f[2].lo), "+v"(f[2].hh), "+v"(f[3].lo), "+v"(f[3].hh) : "n"(N));
    else asm volatile("s_waitcnt lgkmcnt(%4)" : "+v"(f[0].lo), "+v"(f[0].hh), "+v"(f[1].lo), "+v"(f[1].hh) : "n"(N));
}
template <int DV, int KS>
__device__ __forceinline__ void pv_step(VFrag (&cur)[DV / 32], VFrag (&nxt)[DV / 32], unsigned va, const u32x4& pw, f32x16 (&o)[DV / 32]) {
    if constexpr (KS < 3) { vload<DV, KS + 1>(nxt, va); vwait<DV, 2 * (DV / 32)>(cur); } else vwait<DV, 0>(cur);
    const bf16x8 pa = __builtin_bit_cast(bf16x8, pw);
#pragma unroll
    for (int db = 0; db < DV / 32; ++db) {
        const u32x4 w = (u32x4){cur[db].lo.x, cur[db].lo.y, cur[db].hh.x, cur[db].hh.y};
        o[db] = MFMA32(pa, __builtin_bit_cast(bf16x8, w), o[db]);
    }
}
template <int DV, int MODE>
__device__ __forceinline__ void attn_tile(const char* kimg, const char* vimg, const bf16x8 (&qr)[4], f32x16 (&o)[DV / 32], float& m, float& l, int k0, int qpos, float slope2,
                                          bool need_mask, float* wsf, int r32, int hi, int lane) {
    const char* kp = kimg + r32 * 128; const int kx = (r32 >> 1) & 7;
    const unsigned va = (unsigned)(size_t)(lds_cptr)(vimg + ((lane >> 4) & 1) * 32 + (lane & 3) * 8 + (4 * hi + ((lane & 15) >> 2)) * 64);
    VFrag va0[DV / 32], va1[DV / 32];
    vload<DV, 0>(va0, va);
    const float base0 = slope2 * (float)(k0 + 4 * hi - qpos) - m;
    f32x16 c0, c1;
#pragma unroll
    for (int r = 0; r < 16; ++r) { const float cst = (float)((r & 3) + 8 * (r >> 2)); c0[r] = fmaf(slope2, cst, base0); c1[r] = fmaf(slope2, cst + 32.0f, base0); }
    bf16x8 kf[8];
#pragma unroll
    for (int d0 = 0; d0 < 4; ++d0) { const int po = ((2 * d0 + hi) ^ kx) * 16; kf[2 * d0] = *(const bf16x8*)(kp + po); kf[2 * d0 + 1] = *(const bf16x8*)(kp + 4096 + po); }
    __builtin_amdgcn_sched_barrier(0);
#pragma unroll
    for (int d0 = 0; d0 < 4; ++d0) { c0 = MFMA32(kf[2 * d0], qr[d0], c0); c1 = MFMA32(kf[2 * d0 + 1], qr[d0], c1); }
    if (need_mask) {
        const int kb = k0 + 4 * hi;
#pragma unroll
        for (int r = 0; r < 16; ++r) {
            const int key = kb + (r & 3) + 8 * (r >> 2);
            bool v0 = key <= qpos, v1 = key + 32 <= qpos;
            if (MODE == 1) { v0 = v0 && (key > qpos - 128); v1 = v1 && (key + 32 > qpos - 128); }
            c0[r] = v0 ? c0[r] : -INFINITY; c1[r] = v1 ? c1[r] : -INFINITY;
        }
    }
    const float rm = rowmax32(c0, c1);
    if (__any(rm > 8.0f)) {
        const float delta = fmaxf(rm, 0.f); m += delta; const float alpha = exp2f(-delta); l *= alpha;
#pragma unroll
        for (int r = 0; r < 16; ++r) { c0[r] -= delta; c1[r] -= delta; }
        if (hi == 0) wsf[r32] = alpha;
        __builtin_amdgcn_s_waitcnt(0xc07f);
        int q4 = 4 * hi; asm volatile("" : "+v"(q4));
        const float* wb = wsf + q4;
#pragma unroll
        for (int r = 0; r < 16; ++r) { const float a = wb[(r & 3) + 8 * (r >> 2)];
#pragma unroll
            for (int db = 0; db < DV / 32; ++db) o[db][r] *= a; }
    }
#pragma unroll
    for (int r = 0; r < 16; ++r) { c0[r] = __builtin_amdgcn_exp2f(c0[r]); c1[r] = __builtin_amdgcn_exp2f(c1[r]); }
    {
        typedef float f32x2 __attribute__((ext_vector_type(2)));
        f32x2 t[8];
#pragma unroll
        for (int r = 0; r < 8; ++r) t[r] = (f32x2){c0[2 * r], c0[2 * r + 1]} + (f32x2){c1[2 * r], c1[2 * r + 1]};
#pragma unroll
        for (int r = 0; r < 4; ++r) t[r] = t[r] + t[r + 4];
        t[0] = (t[0] + t[2]) + (t[1] + t[3]);
        l += t[0].x + t[0].y;
    }
    u32x4 pw[4];
#pragma unroll
    for (int s = 0; s < 2; ++s) {
        pw[s] = (u32x4){cvtpk(c0[8 * s], c0[8 * s + 1]), cvtpk(c0[8 * s + 2], c0[8 * s + 3]), cvtpk(c0[8 * s + 4], c0[8 * s + 5]), cvtpk(c0[8 * s + 6], c0[8 * s + 7])};
        pw[2 + s] = (u32x4){cvtpk(c1[8 * s], c1[8 * s + 1]), cvtpk(c1[8 * s + 2], c1[8 * s + 3]), cvtpk(c1[8 * s + 4], c1[8 * s + 5]), cvtpk(c1[8 * s + 6], c1[8 * s + 7])};
    }
    pv_step<DV, 0>(va0, va1, va, pw[0], o);
    pv_step<DV, 1>(va1, va0, va, pw[1], o);
    pv_step<DV, 2>(va0, va1, va, pw[2], o);
    pv_step<DV, 3>(va1, va0, va, pw[3], o);
}

template <int DV>
__device__ __forceinline__ void attn_finish(f32x16 (&o)[DV / 32], float l, float extra, float* wsf, float* ost, int r32, int hi) {
    auto rr = __builtin_amdgcn_permlane32_swap(__float_as_uint(l), __float_as_uint(l), false, false);
    const float lt = __uint_as_float(rr[0]) + __uint_as_float(rr[1]) + extra;
    if (hi == 0) wsf[32 + r32] = 1.0f / lt;
    __builtin_amdgcn_s_waitcnt(0xc07f);
    int q4 = 4 * hi; asm volatile("" : "+v"(q4));
    const float* wb = wsf + 32 + q4; float* ob = ost + q4 * (DV + 4) + r32;
#pragma unroll
    for (int r = 0; r < 16; ++r) { const int qc = (r & 3) + 8 * (r >> 2); const float a = wb[qc];
#pragma unroll
        for (int db = 0; db < DV / 32; ++db) ob[qc * (DV + 4) + db * 32] = o[db][r] * a; }
}

__device__ __forceinline__ void diff_unit(const Params& p, int b, int h, int qblk, float lam) {
    const int tid = opaque_tid(), lane = tid & 63, wid = wave_of(tid), r32 = lane & 31, hi = lane >> 5, map = wid >> 1, chunk = wid & 1;
    const bf16_t* base = p.proj + (size_t)b * S * INW;
    const int q0 = qblk * 64 + chunk * 32, qpos = q0 + r32;
    const float slope2 = exp2f(-8.0f * (float)(9 + h) / 12.0f) * LOG2E;
    float* wsf = (float*)(smem + ATT_WS) + wid * 64;
    bf16x8 qr[4];
    { const bf16_t* qp = base + (size_t)qpos * INW + h * 128 + map * 64 + hi * 8;
#pragma unroll
      for (int d0 = 0; d0 < 4; ++d0) qr[d0] = *(const bf16x8*)(qp + d0 * 16); }
    f32x16 o[4];
#pragma unroll
    for (int db = 0; db < 4; ++db) o[db] = f32x16{};
    float m = 0.f, l = 0.f;
    const int kc0 = ((lane & 7) ^ (lane >> 4)) * 8;
    const bf16_t* kg = base + (size_t)(32 * (wid & 1) + (lane >> 3)) * INW + 512 + h * 128 + (wid >> 1) * 64;
    const bf16_t* vg = base + (size_t)(32 * (wid & 1) + ((lane >> 2) & 7)) * INW + 1024 + h * 128 + (wid >> 1) * 64 + (lane >> 5) * 32 + (lane & 3) * 8;
    const int kdst = (wid >> 1) * 8192 + (wid & 1) * 4096, vdst = 16384 + (wid & 1) * 8192 + (wid >> 1) * 1024;
    const int nt = qblk + 1;
#define GLDS(gp, off) __builtin_amdgcn_global_load_lds((const unsigned*)(gp), (__attribute__((address_space(3))) unsigned*)(smem + (off)), 16, 0, 0)
#define DIFF_STAGE(t, st) do { const size_t go = (size_t)(t) * 64 * INW; const int sb_ = (st) * 32768; \
        GLDS(kg + go + kc0, sb_ + kdst); GLDS(kg + go + (size_t)8 * INW + (kc0 ^ 32), sb_ + kdst + 1024); \
        GLDS(kg + go + (size_t)16 * INW + kc0, sb_ + kdst + 2048); GLDS(kg + go + (size_t)24 * INW + (kc0 ^ 32), sb_ + kdst + 3072); \
        _Pragma("unroll") for (int kb = 0; kb < 4; ++kb) GLDS(vg + go + (size_t)kb * 8 * INW, sb_ + vdst + kb * 2048); } while (0)
    DIFF_STAGE(0, 0);
    __syncthreads();
    for (int t = 0; t < nt; ++t) {
        if (t + 1 < nt) DIFF_STAGE(t + 1, (t + 1) & 1);
        const char* sb = smem + (t & 1) * 32768;
        attn_tile<128, 0>(sb + map * 8192, sb + 16384, qr, o, m, l, t * 64, qpos, slope2, t * 64 + 63 > q0, wsf, r32, hi, lane);
        __syncthreads();
    }
#undef DIFF_STAGE
    float* ost = (float*)smem + wid * (32 * 132);
    attn_finish<128>(o, l, 0.f, wsf, ost, r32, hi);
    __syncthreads();
    {
        int tq = tid; asm volatile("" : "+v"(tq));
        const int q = tq >> 2, dq = tq & 3, ch = q >> 5, qi = q & 31;
        const float* o1 = (const float*)smem + ch * (32 * 132) + qi * 132 + dq * 32;
        const float* o2 = (const float*)smem + (2 + ch) * (32 * 132) + qi * 132 + dq * 32;
        float v[32]; float ss = 0.f;
#pragma unroll
        for (int i = 0; i < 8; ++i) { const f32x4 a = *(const f32x4*)(o1 + 4 * i), c = *(const f32x4*)(o2 + 4 * i);
#pragma unroll
            for (int e = 0; e < 4; ++e) { const float x = a[e] - lam * c[e]; v[4 * i + e] = x; ss += x * x; } }
        ss += __shfl_xor(ss, 1); ss += __shfl_xor(ss, 2);
        const float rn = rsqrtf(ss * (1.0f / 128.0f) + LN_EPS) * (1.0f - LAMBDA_INIT);
        const float* g = p.subln_g + dq * 32;
        bf16_t* op = p.attn + tm_act(b * S + qblk * 64 + q, h * 128 + dq * 32);
#pragma unroll
        for (int i = 0; i < 4; ++i) { u32x4 w;
            w.x = cvtpk(v[8 * i] * rn * g[8 * i], v[8 * i + 1] * rn * g[8 * i + 1]); w.y = cvtpk(v[8 * i + 2] * rn * g[8 * i + 2], v[8 * i + 3] * rn * g[8 * i + 3]);
            w.z = cvtpk(v[8 * i + 4] * rn * g[8 * i + 4], v[8 * i + 5] * rn * g[8 * i + 5]); w.w = cvtpk(v[8 * i + 6] * rn * g[8 * i + 6], v[8 * i + 7] * rn * g[8 * i + 7]);
            *(u32x4*)(op + 8 * i) = w; }
    }
    __syncthreads();
}

__device__ __forceinline__ void swa_unit(const Params& p, int b, int kv, int qc) {
    const int tid = opaque_tid(), lane = tid & 63, wid = wave_of(tid), r32 = lane & 31, hi = lane >> 5, hq = kv * 4 + wid;
    const bf16_t* base = p.proj + (size_t)b * S * INW;
    const int q0 = qc * 32, qpos = q0 + r32;
    const float slope2 = exp2f(-8.0f * (float)(1 + hq) / 12.0f) * LOG2E;
    float* wsf = (float*)(smem + ATT_WS) + wid * 64;
    bf16x8 qr[4];
    { const bf16_t* qp = base + (size_t)qpos * INW + 1536 + hq * 64 + hi * 8;
#pragma unroll
      for (int d0 = 0; d0 < 4; ++d0) qr[d0] = *(const bf16x8*)(qp + d0 * 16); }
    f32x16 o[2]; o[0] = f32x16{}; o[1] = f32x16{};
    float m = 0.f, l = 0.f;
    const int kc0 = ((lane & 7) ^ (lane >> 4)) * 8;
    const bf16_t* kg = base + (size_t)(16 * wid + (lane >> 3)) * INW + 2048 + kv * 64;
    const bf16_t* vg = base + (size_t)(16 * wid + ((lane >> 2) & 7)) * INW + 2176 + kv * 64 + (lane >> 5) * 32 + (lane & 3) * 8;
    const int t_lo = (q0 - 127 > 0 ? q0 - 127 : 0) >> 6, t_hi = (q0 + 31) >> 6;
#define SWA_STAGE(t, st) do { const size_t go = (size_t)(t) * 64 * INW; const int sb_ = (st) * 32768; \
        GLDS(kg + go + kc0, sb_ + wid * 2048); GLDS(kg + go + (size_t)8 * INW + (kc0 ^ 32), sb_ + wid * 2048 + 1024); \
        GLDS(vg + go, sb_ + 16384 + wid * 2048); GLDS(vg + go + (size_t)8 * INW, sb_ + 16384 + wid * 2048 + 1024); } while (0)
    SWA_STAGE(t_lo, 0);
    __syncthreads();
    for (int t = t_lo; t <= t_hi; ++t) {
        const int st = (t - t_lo) & 1;
        if (t < t_hi) SWA_STAGE(t + 1, st ^ 1);
        const char* sb = smem + st * 32768;
        attn_tile<64, 1>(sb, sb + 16384, qr, o, m, l, t * 64, qpos, slope2, true, wsf, r32, hi, lane);
        __syncthreads();
    }
#undef SWA_STAGE
    float* ost = (float*)smem + wid * (32 * 68);
    attn_finish<64>(o, l, exp2f(p.sinks[hq] * LOG2E - m), wsf, ost, r32, hi);
    __syncthreads();
    {
        int tq = tid; asm volatile("" : "+v"(tq));
        const int q = tq >> 3, g = (tq >> 1) & 3, dh = tq & 1;
        const float* os = (const float*)smem + g * (32 * 68) + q * 68 + dh * 32;
        bf16_t* op = p.attn + tm_act(b * S + q0 + q, 512 + (kv * 4 + g) * 64 + dh * 32);
#pragma unroll
        for (int i = 0; i < 4; ++i) { const f32x4 a = *(const f32x4*)(os + 8 * i), c = *(const f32x4*)(os + 8 * i + 4);
            u32x4 w; w.x = cvtpk(a[0], a[1]); w.y = cvtpk(a[2], a[3]); w.z = cvtpk(c[0], c[1]); w.w = cvtpk(c[2], c[3]);
            *(u32x4*)(op + 8 * i) = w; }
    }
    __syncthreads();
}

constexpr int ATT_ITEMS = 4096;
__device__ __forceinline__ void attn_item(const Params& p, int item, float lam) {
    if (item < 2048) {
        const int bh = item >> 4, j = item & 15, b = bh >> 2, h = bh & 3;
        diff_unit(p, b, h, 31 - j, lam);
        diff_unit(p, b, h, j, lam);
    } else {
        const int it = item - 2048, bkv = it >> 5, qq = it & 31, b = bkv >> 1, kv = bkv & 1;
        swa_unit(p, b, kv, 2 * qq);
        swa_unit(p, b, kv, 2 * qq + 1);
    }
}

struct EpiY1 {
    static constexpr bool PERM = true;
    const float* x; const float* mod; bf16_t* y;
    __device__ __forceinline__ void operator()(f32x4 (&acc)[4][8], int mb, int nb, int lane, char*) {
        const int b = mb / S;
        const float* xb = x + (size_t)(mb + (lane & 15)) * D + nb + (lane >> 4) * 8;
        const float* gb = mod + b * MODW + G1 + nb + (lane >> 4) * 8;
        bf16_t* yb = y + (size_t)(mb + (lane & 15)) * D + nb + (lane >> 4) * 8;
        f32x4 xv[2][4][2], gv[2][2];
#define Y1_LD(dst, ptr) asm volatile("global_load_dwordx4 %0, %1, off" : "=v"(dst) : "v"(ptr))
#define Y1_ISSUE(s, g) do { Y1_LD(gv[s][0], gb + (g) * 32); Y1_LD(gv[s][1], gb + (g) * 32 + 4); \
        _Pragma("unroll") for (int i_ = 0; i_ < 4; ++i_) { Y1_LD(xv[s][i_][0], xb + (g) * 32 + (size_t)i_ * 16 * D); Y1_LD(xv[s][i_][1], xb + (g) * 32 + (size_t)i_ * 16 * D + 4); } } while (0)
#define Y1_TIE(s) "+v"(gv[s][0]), "+v"(gv[s][1]), "+v"(xv[s][0][0]), "+v"(xv[s][0][1]), "+v"(xv[s][1][0]), "+v"(xv[s][1][1]), "+v"(xv[s][2][0]), "+v"(xv[s][2][1]), "+v"(xv[s][3][0]), "+v"(xv[s][3][1])
        Y1_ISSUE(0, 0);
#pragma unroll
        for (int g = 0; g < 4; ++g) {
            const int s = g & 1;
            if (g < 3) { Y1_ISSUE(s ^ 1, g + 1);
                if (s == 0) asm volatile("s_waitcnt vmcnt(10)" : Y1_TIE(0)); else asm volatile("s_waitcnt vmcnt(10)" : Y1_TIE(1)); }
            else asm volatile("s_waitcnt vmcnt(0)" : Y1_TIE(1));
#pragma unroll
            for (int i = 0; i < 4; ++i) {
                const f32x4 y0 = xv[s][i][0] * ALPHA + gv[s][0] * acc[i][2 * g], y1v = xv[s][i][1] * ALPHA + gv[s][1] * acc[i][2 * g + 1];
                u32x4 w; w.x = cvtpk(y0[0], y0[1]); w.y = cvtpk(y0[2], y0[3]); w.z = cvtpk(y1v[0], y1v[1]); w.w = cvtpk(y1v[2], y1v[3]);
                *(u32x4*)(yb + g * 32 + (size_t)i * 16 * D) = w;
            }
        }
#undef Y1_TIE
#undef Y1_ISSUE
#undef Y1_LD
    }
};

#define DPP_ADD(v, ctrl) ((v) + __int_as_float(__builtin_amdgcn_update_dpp(0, __float_as_int(v), (ctrl), 0xf, 0xf, false)))
__device__ __forceinline__ float wave_sum(float v) {
    v = DPP_ADD(v, 0xB1);
    v = DPP_ADD(v, 0x4E);
    v = DPP_ADD(v, 0x141);
    v = DPP_ADD(v, 0x140);
    { auto r = __builtin_amdgcn_permlane16_swap(__float_as_uint(v), __float_as_uint(v), false, false); v = __uint_as_float(r[0]) + __uint_as_float(r[1]); }
    { auto r = __builtin_amdgcn_permlane32_swap(__float_as_uint(v), __float_as_uint(v), false, false); v = __uint_as_float(r[0]) + __uint_as_float(r[1]); }
    return v;
}

#define DPP_MAX(v, ctrl) fmaxf((v), __int_as_float(__builtin_amdgcn_update_dpp(0, __float_as_int(v), (ctrl), 0xf, 0xf, false)))
__device__ __forceinline__ float wave_max(float v) {
    v = DPP_MAX(v, 0xB1); v = DPP_MAX(v, 0x4E); v = DPP_MAX(v, 0x141); v = DPP_MAX(v, 0x140);
    { auto r = __builtin_amdgcn_permlane16_swap(__float_as_uint(v), __float_as_uint(v), false, false); v = fmaxf(__uint_as_float(r[0]), __uint_as_float(r[1])); }
    { auto r = __builtin_amdgcn_permlane32_swap(__float_as_uint(v), __float_as_uint(v), false, false); v = fmaxf(__uint_as_float(r[0]), __uint_as_float(r[1])); }
    return v;
}
__device__ __forceinline__ void ln1_rows(const Params& p, int r0) {
    const int tid = opaque_tid(), lane = tid & 63, wid = wave_of(tid), b = r0 / S;
    f32x4 g[4], be[4], sc[4], sh[4];
#pragma unroll
    for (int v = 0; v < 4; ++v) { const int c = 8 * lane + 512 * (v >> 1) + 4 * (v & 1); g[v] = *(const f32x4*)(p.ln1_g + c); be[v] = *(const f32x4*)(p.ln1_b + c);
        sc[v] = *(const f32x4*)(p.mod + b * MODW + SC2 + c); sh[v] = *(const f32x4*)(p.mod + b * MODW + SH2 + c); }
    u32x4 yw[4][2];
    const bf16_t* yb = p.y1 + (size_t)(r0 + wid * 32) * D + 8 * lane;
#define LN_LD(dst, ptr) asm volatile("global_load_dwordx4 %0, %1, off" : "=v"(dst) : "v"(ptr))
#define LN_ISSUE(s, row) do { const bf16_t* yp_ = yb + (size_t)(row) * D; LN_LD(yw[s][0], yp_); LN_LD(yw[s][1], yp_ + 512); } while (0)
    LN_ISSUE(0, 0); LN_ISSUE(1, 1);
#pragma unroll 1
    for (int i0 = 0; i0 < 32; i0 += 4) {
#pragma unroll
      for (int r = 0; r < 4; ++r) {
        const int i = i0 + r;
        { const int nx = (i + 2 < 32) ? i + 2 : 31; LN_ISSUE((r + 2) & 3, nx); }
        asm volatile("s_waitcnt vmcnt(4)" : "+v"(yw[r][0]), "+v"(yw[r][1]));
        const size_t ro = (size_t)(r0 + wid * 32 + i) * D;
        f32x4 v[4]; float s = 0.f;
#pragma unroll
        for (int j = 0; j < 2; ++j) { const u32x4 w4 = yw[r][j];
            v[2 * j] = (f32x4){bflo(w4.x), bfhi(w4.x), bflo(w4.y), bfhi(w4.y)}; v[2 * j + 1] = (f32x4){bflo(w4.z), bfhi(w4.z), bflo(w4.w), bfhi(w4.w)}; }
#pragma unroll
        for (int k = 0; k < 4; ++k) s += (v[k][0] + v[k][1]) + (v[k][2] + v[k][3]);
        const float mu = wave_sum(s) * (1.0f / D);
        float q = 0.f;
#pragma unroll
        for (int k = 0; k < 4; ++k) { v[k] = v[k] - mu; q += (v[k][0] * v[k][0] + v[k][1] * v[k][1]) + (v[k][2] * v[k][2] + v[k][3] * v[k][3]); }
        const float rs = rsqrtf(wave_sum(q) * (1.0f / D) + LN_EPS);
        u32x4 hw2[2];
#pragma unroll
        for (int j = 0; j < 2; ++j) {
            const f32x4 xo0 = v[2 * j] * rs * g[2 * j] + be[2 * j], xo1 = v[2 * j + 1] * rs * g[2 * j + 1] + be[2 * j + 1];
            u32x4 xw; xw.x = cvtpk(xo0[0], xo0[1]); xw.y = cvtpk(xo0[2], xo0[3]); xw.z = cvtpk(xo1[0], xo1[1]); xw.w = cvtpk(xo1[2], xo1[3]);
            *(u32x4*)(p.x1 + ro + 8 * lane + 512 * j) = xw;
            const f32x4 h0 = xo0 * (sc[2 * j] + 1.0f) + sh[2 * j], h1 = xo1 * (sc[2 * j + 1] + 1.0f) + sh[2 * j + 1];
            u32x4 w; w.x = cvtpk(h0[0], h0[1]); w.y = cvtpk(h0[2], h0[3]); w.z = cvtpk(h1[0], h1[1]); w.w = cvtpk(h1[2], h1[3]);
            *(u32x4*)(p.hbuf + tm_act(r0 + wid * 32 + i, 8 * lane + 512 * j)) = w;
            hw2[j] = w;
        }
        {
            float am = 0.f;
#pragma unroll
            for (int j = 0; j < 2; ++j)
#pragma unroll
                for (int q = 0; q < 4; ++q) am = fmaxf(am, fmaxf(fabsf(bflo(hw2[j][q])), fabsf(bfhi(hw2[j][q]))));
            am = wave_max(am);
            am = fmaxf(am, 1e-30f); const float inv = 119.0f / am;
#pragma unroll
            for (int j = 0; j < 2; ++j) {
                unsigned pa = 0u, pb = 0u;
#pragma unroll
                for (int q = 0; q < 4; ++q) {
                    const int x0 = (int)rintf(bflo(hw2[j][q]) * inv), x1 = (int)rintf(bfhi(hw2[j][q]) * inv);
                    const int b0 = ((x0 + 8) & 15) - 8, b1 = ((x1 + 8) & 15) - 8, a0 = (x0 - b0) >> 4, a1 = (x1 - b1) >> 4;
                    pa |= ((unsigned)a0 & 15u) << (8 * q); pa |= ((unsigned)a1 & 15u) << (8 * q + 4); pb |= ((unsigned)b0 & 15u) << (8 * q); pb |= ((unsigned)b1 & 15u) << (8 * q + 4);
                }
                unsigned* hp = p.hq + (size_t)(r0 + wid * 32 + i) * 256 + ((lane >> 2) + 16 * j) * 8 + (lane & 3);
                hp[0] = pa; hp[4] = pb;
            }
            if (lane == 0) p.hsc[r0 + wid * 32 + i] = am * (1.0f / 119.0f);
        }
      }
    }
    asm volatile("s_waitcnt vmcnt(0)" ::: "memory");
#undef LN_ISSUE
#undef LN_LD
}

__device__ __forceinline__ int f2ord(float v) { const int u = __float_as_int(v); return u ^ ((u >> 31) & 0x7fffffff); }
__device__ __forceinline__ float ord2f(int k) { return __int_as_float(k ^ ((k >> 31) & 0x7fffffff)); }
__device__ __forceinline__ void cex(int& a, int& b) { const int mx = max(a, b), mn = min(a, b); a = mx; b = mn; }
__device__ __forceinline__ void sort16_desc(int (&a)[16]) {
#pragma unroll
    for (int k = 2; k <= 16; k <<= 1)
#pragma unroll
        for (int j = k >> 1; j > 0; j >>= 1)
#pragma unroll
            for (int i = 0; i < 16; ++i) { const int l = i ^ j; if (l > i) { if ((i & k) == 0) cex(a[i], a[l]); else cex(a[l], a[i]); } }
}
__device__ __forceinline__ void merge16_desc(int (&a)[16]) {
#pragma unroll
    for (int j = 8; j > 0; j >>= 1)
#pragma unroll
        for (int i = 0; i < 16; ++i) { const int l = i ^ j; if (l > i) cex(a[i], a[l]); }
}
__device__ __forceinline__ void top16_merge(int (&top)[16], const int (&c)[16]) {
#pragma unroll
    for (int i = 0; i < 16; ++i) top[i] = max(top[i], c[15 - i]);
    merge16_desc(top);
}

struct EpiTopk {
    static constexpr bool PERM = false;
    int* hk; int hp0;
    __device__ __forceinline__ void operator()(f32x4 (&acc)[4][8], int mb, int nb, int lane, char* lds) {
        const int tid = opaque_tid(), wid = wave_of(tid), wm = wid >> 1, wn = wid & 1;
#pragma unroll 1
        for (int pass = 0; pass < 2; ++pass) {
            if (wn == pass) {
#pragma unroll
                for (int i = 0; i < 4; ++i) {
                    const int row = wm * 64 + i * 16 + (lane & 15);
#pragma unroll
                    for (int j = 0; j < 8; ++j) { const int c = j * 4 + (lane >> 4); *(f32x4*)(lds + row * 512 + ((c ^ (2 * (row & 7))) << 4)) = acc[i][j]; }
                }
            }
            __syncthreads();
            const int row = tid >> 1, half = tid & 1, sw = 2 * (row & 7);
            const char* rp = lds + row * 512;
            int top[16];
#pragma unroll
            for (int gq = 0; gq < 4; ++gq) {
                int c[16];
#pragma unroll
                for (int ii = 0; ii < 4; ++ii) {
                    const int ch = 2 * (4 * gq + ii) + half;
                    const f32x4 v = *(const f32x4*)(rp + ((ch ^ sw) << 4));
#pragma unroll
                    for (int e = 0; e < 4; ++e) c[4 * ii + e] = (f2ord(v[e]) & ~127) | (127 - (ch * 4 + e));
                }
                sort16_desc(c);
                if (gq == 0) {
#pragma unroll
                    for (int i = 0; i < 16; ++i) top[i] = c[i];
                } else top16_merge(top, c);
            }
            int oth[16];
#pragma unroll
            for (int i = 0; i < 16; ++i) oth[i] = __shfl_xor(top[15 - i], 1);
#pragma unroll
            for (int i = 0; i < 16; ++i) top[i] = max(top[i], oth[i]);
            merge16_desc(top);
            if (half == 0) {
                int* op = hk + ((size_t)(mb - wm * 64 + row) * 16 + hp0 + pass) * 16;
#pragma unroll
                for (int i = 0; i < 4; ++i) *(u32x4*)(op + 4 * i) = (u32x4){(unsigned)top[4 * i], (unsigned)top[4 * i + 1], (unsigned)top[4 * i + 2], (unsigned)top[4 * i + 3]};
            }
            __syncthreads();
        }
    }
};

__device__ __forceinline__ void route_combine(const Params& p, int r0) {
    const int tid = opaque_tid();
    for (int it = 0; it < 4; ++it) {
        const int th = it * 256 + tid, t = r0 + (th >> 3), h = th & 7;
        const int* ka = p.hk + ((size_t)t * 16 + 2 * h) * 16; const int* kb = ka + 16;
        float va[16], vb[16];
        int* lk = (int*)smem + tid * 33;
#pragma unroll
        for (int i = 0; i < 4; ++i) { const u32x4 a = *(const u32x4*)(ka + 4 * i), b = *(const u32x4*)(kb + 4 * i);
#pragma unroll
            for (int e = 0; e < 4; ++e) { va[4 * i + e] = ord2f((int)a[e] & ~127); vb[4 * i + e] = ord2f((int)b[e] & ~127);
                lk[4 * i + e] = (127 - ((int)a[e] & 127)) * 128; lk[16 + 4 * i + e] = 127 - ((int)b[e] & 127); } }
        int top[16];
        {
            int c[16];
#pragma unroll
            for (int j = 0; j < 16; ++j) c[j] = (f2ord(va[0] + vb[j]) & ~255) | (255 - j);
            sort16_desc(c);
#pragma unroll
            for (int i = 0; i < 16; ++i) top[i] = c[i];
#pragma unroll
            for (int j = 0; j < 8; ++j) c[j] = (f2ord(va[1] + vb[j]) & ~255) | (255 - (16 + j));
#pragma unroll
            for (int j = 0; j < 5; ++j) c[8 + j] = (f2ord(va[2] + vb[j]) & ~255) | (255 - (32 + j));
#pragma unroll
            for (int j = 0; j < 3; ++j) c[13 + j] = (f2ord(va[3] + vb[j]) & ~255) | (255 - (48 + j));
            sort16_desc(c); top16_merge(top, c);
            c[0] = (f2ord(va[3] + vb[3]) & ~255) | (255 - (48 + 3));
#pragma unroll
            for (int j = 0; j < 3; ++j) c[1 + j] = (f2ord(va[4] + vb[j]) & ~255) | (255 - (64 + j));
#pragma unroll
            for (int i = 5; i < 8; ++i)
#pragma unroll
                for (int j = 0; j < 2; ++j) c[4 + (i - 5) * 2 + j] = (f2ord(va[i] + vb[j]) & ~255) | (255 - (16 * i + j));
#pragma unroll
            for (int i = 8; i < 14; ++i) c[10 + (i - 8)] = (f2ord(va[i] + vb[0]) & ~255) | (255 - (16 * i));
            sort16_desc(c); top16_merge(top, c);
            c[0] = (f2ord(va[14] + vb[0]) & ~255) | (255 - 16 * 14); c[1] = (f2ord(va[15] + vb[0]) & ~255) | (255 - 16 * 15);
            cex(c[0], c[1]);
#pragma unroll
            for (int i = 2; i < 16; ++i) c[i] = (int)0x80000000;
            top16_merge(top, c);
        }
        float e[16], sum = 0.f; const float s0 = ord2f(top[0] & ~255);
#pragma unroll
        for (int k = 0; k < 16; ++k) { e[k] = __expf(ord2f(top[k] & ~255) - s0); sum += e[k]; }
        const float rs = 1.0f / sum;
        int* eo = p.eidx + (size_t)t * 128 + h * 16; float* go = p.gw + (size_t)t * 128 + h * 16;
#pragma unroll
        for (int k = 0; k < 16; ++k) { const int pos = 255 - (top[k] & 255); eo[k] = lk[pos >> 4] + lk[16 + (pos & 15)]; go[k] = e[k] * rs; }
    }
}

typedef __bf16 bf16x2_t __attribute__((ext_vector_type(2)));
__device__ __forceinline__ float dot2bf(unsigned a, unsigned b, float c) { return __builtin_amdgcn_fdot2_f32_bf16(__builtin_bit_cast(bf16x2_t, a), __builtin_bit_cast(bf16x2_t, b), c, false); }
__device__ __forceinline__ float gelu_erf(float s) { return 0.5f * s * (1.0f + erff(s * 0.70710678118654752f)); }

#define DPP_IADD(v, ctrl) ((v) + __builtin_amdgcn_update_dpp(0, (v), (ctrl), 0xf, 0xf, false))
__device__ __forceinline__ int wave_isum(int v) {
    v = DPP_IADD(v, 0xB1); v = DPP_IADD(v, 0x4E); v = DPP_IADD(v, 0x141); v = DPP_IADD(v, 0x140);
    { auto r = __builtin_amdgcn_permlane16_swap((unsigned)v, (unsigned)v, false, false); v = (int)(r[0] + r[1]); }
    { auto r = __builtin_amdgcn_permlane32_swap((unsigned)v, (unsigned)v, false, false); v = (int)(r[0] + r[1]); }
    return v;
}
__device__ __forceinline__ float ub0(unsigned w) { return (float)(w & 0xffu); }
__device__ __forceinline__ float ub1(unsigned w) { return (float)((w >> 8) & 0xffu); }
__device__ __forceinline__ float ub2(unsigned w) { return (float)((w >> 16) & 0xffu); }
__device__ __forceinline__ float ub3(unsigned w) { return (float)(w >> 24); }

constexpr int PEER_LVEC = 12288;
constexpr int PEER_LDS = PEER_LVEC + 4 * 16384;
__device__ __forceinline__ void peer_u(const Params& p, int t0, int ntok, int lane) {
    const int li = lane & 31, li16 = li * 16; const bool hi = lane >= 32;
    u32x4 buf[16]; unsigned mbuf[16];
#define PEV(esel, base, j) ({ const int ea__ = __builtin_amdgcn_readlane(esel, (base) + 2 * (j)), eb__ = __builtin_amdgcn_readlane(esel, (base) + 2 * (j) + 1); hi ? eb__ : ea__; })
#define PFU(j, esel, base) do { const int ev_ = PEV(esel, base, j); const int ro_ = ev_ * 512 + li16, mo_ = ev_ * 32 + li;        \
        asm volatile("global_load_dwordx4 %0, %1, %2" : "=v"(buf[j]) : "v"(ro_), "s"(p.u_q)); \
        asm volatile("global_load_ubyte %0, %1, %2" : "=v"(mbuf[j]) : "v"(mo_), "s"(p.u_m)); } while (0)
#define MBYTE(j) ({ asm volatile("s_waitcnt vmcnt(22)" : "+v"(mbuf[j])); mbuf[j]; })
#define DATA_R(j) ({ asm volatile("s_waitcnt vmcnt(22)" : "+v"(buf[j])); buf[j]; })
#define H_LOAD(tt) do { const u32x4 ha_ = *(const u32x4*)(p.hq + (size_t)(tt) * 256 + li * 8), hb_ = *(const u32x4*)(p.hq + (size_t)(tt) * 256 + li * 8 + 4); \
            _Pragma("unroll") for (int k = 0; k < 4; ++k) { hA[k] = ha_[k]; hB[k] = hb_[k]; } hs = p.hsc[(tt)]; } while (0)
    int e0 = p.eidx[(size_t)t0 * 128 + lane], e1 = p.eidx[(size_t)t0 * 128 + 64 + lane];
#pragma unroll
    for (int j = 0; j < 16; ++j) PFU(j, e0, 0);
    unsigned hA[4], hB[4]; float hs;
    H_LOAD(t0);
    asm volatile("s_waitcnt vmcnt(0)" ::: "memory");
#pragma unroll 1
    for (int it = 0; it < ntok; ++it) {
        const int t = t0 + it;
        const int tn = (it + 1 < ntok) ? t + 1 : t;
        const int e0n = p.eidx[(size_t)tn * 128 + lane], e1n = p.eidx[(size_t)tn * 128 + 64 + lane];
        if (it) H_LOAD(t);
        const float g0 = p.gw[(size_t)t * 128 + lane], g1 = p.gw[(size_t)t * 128 + 64 + lane], us0 = p.u_sc[e0], us1 = p.u_sc[e1], vs0 = p.v_sc[e0] * 255.0f, vs1 = p.v_sc[e1] * 255.0f;
        int sA = 0, sB = 0;
#define DPPM(v, ctrl) __builtin_amdgcn_update_dpp(0, (v), (ctrl), 0xf, 0xf, false)
#define PA_BLOCK(jb, DATA, PREFETCH) do { int sq_[4]; \
            _Pragma("unroll") for (int q = 0; q < 4; ++q) { const int j_ = 4 * (jb) + q; const u32x4 dd_ = DATA(j_); int sa2_ = 0, sb2_ = 0; \
                _Pragma("unroll") for (int k = 0; k < 4; ++k) { sa2_ = __builtin_amdgcn_sdot8((int)hA[k], (int)dd_[k], sa2_, false); sb2_ = __builtin_amdgcn_sdot8((int)hB[k], (int)dd_[k], sb2_, false); } \
                sq_[q] = __mul24((sa2_ << 4) + sb2_, (int)MBYTE(j_)); PREFETCH(j_); }       \
            const int r0_ = (b0_ ? sq_[2] : sq_[0]) + DPPM(b0_ ? sq_[0] : sq_[2], 0xB1), r1_ = (b0_ ? sq_[3] : sq_[1]) + DPPM(b0_ ? sq_[1] : sq_[3], 0xB1); \
            int u_ = (b1_ ? r1_ : r0_) + DPPM(b1_ ? r0_ : r1_, 0x4E);              \
            u_ += DPPM(u_, 0x124); u_ += DPPM(u_, 0x128);                         \
            { auto r_ = __builtin_amdgcn_permlane16_swap((unsigned)u_, (unsigned)u_, false, false); u_ = (int)(r_[0] + r_[1]); }     \
            { auto r_ = __builtin_amdgcn_permlane32_swap((unsigned)u_, (unsigned)u_, false, false); const int lo_ = (int)r_[0], hi_ = (int)r_[1];    \
                \
                \
              const int glA_ = DPPM(lo_, 0xF5), glB_ = DPPM(lo_, 0xA0), ghA_ = DPPM(hi_, 0xF5), ghB_ = DPPM(hi_, 0xA0); \
              const int gl_ = b2_ ? glA_ : glB_, gh_ = b2_ ? ghA_ : ghB_; \
              const int val_ = b0_ ? gh_ : gl_; sT = ((lrel >> 3) == (jb)) ? val_ : sT; } \
            __builtin_amdgcn_sched_barrier(0); } while (0)
        asm volatile(".p2align 6\n\ts_nop 0\n\ts_nop 0\n\ts_nop 0\n\ts_nop 0\n\ts_nop 0\n\ts_nop 0\n\ts_nop 0\n\ts_nop 0\n\ts_nop 0\n\ts_nop 0\n\ts_nop 0\n\ts_nop 0\n\ts_nop 0\n\ts_nop 0\n\ts_nop 0\n\ts_nop 0");
#pragma unroll 1
        for (int g = 0; g < 4; ++g) {
            int lane_ = lane; asm volatile("" : "+v"(lane_));
            int en_ = (g == 0) ? e0 : ((g == 3) ? e0n : e1); asm volatile("" : "+v"(en_));
            const int nb_ = (g & 1) ? 0 : 32;
            int sT = (g < 2) ? sA : sB;
            const bool b0_ = lane_ & 1, b1_ = lane_ & 2, b2_ = lane_ & 4;
            const int lrel = lane_ - 32 * (g & 1);
#define PF(j) PFU(j, en_, nb_)
#pragma unroll
            for (int jb = 0; jb < 4; ++jb) PA_BLOCK(jb, DATA_R, PF);
#undef PF
            if (g < 2) sA = sT; else sB = sT;
        }
#undef PA_BLOCK
#undef DPPM
        p.gw[(size_t)t * 128 + lane] = g0 * gelu_erf((float)sA * (hs * us0)) * vs0;
        p.gw[(size_t)t * 128 + 64 + lane] = g1 * gelu_erf((float)sB * (hs * us1)) * vs1;
        e0 = e0n; e1 = e1n;
    }
#undef PEV
#undef PFU
#undef MBYTE
#undef DATA_R
#undef H_LOAD
}

__device__ __forceinline__ void peer_v(const Params& p, int t0, int ntok, int lane, int wid, float* outbase, size_t tmask, const float* lvec  ) {
    const int li = lane & 31; const bool hi = lane >= 32;
    const int lring = PEER_LVEC + wid * 16384;
    int lx16[4];
#pragma unroll
    for (int s4 = 0; s4 < 4; ++s4) lx16[s4] = (li ^ (2 * s4 + (hi ? 1 : 0))) * 16;
#define ISSUE_V(s, esel, ln) do { const int ea__ = __builtin_amdgcn_readlane(esel, (ln)), eb__ = __builtin_amdgcn_readlane(esel, (ln) + 1); const int ev_ = hi ? eb__ : ea__; \
        const unsigned char* gp_ = p.v_q + (size_t)ev_ * 512 + lx16[(s) & 3]; \
        __builtin_amdgcn_global_load_lds((const unsigned*)gp_, (__attribute__((address_space(3))) unsigned*)(smem + lring + (s) * 1024), 16, 0, 0); } while (0)
    const int trr = (lane & 15) >> 1, trc = lane & 1, trg = lane >> 4;
    const unsigned tr_base = (unsigned)(size_t)(lds_cptr)(smem + lring + (trr >> 1) * 1024 + (trr & 1) * 512 + ((trg ^ (trr & 3)) << 4) + trc * 8);
    const unsigned trE = tr_base + ((trr >> 2) ? 64u : 0u), trO = tr_base - ((trr >> 2) ? 64u : 0u);
#define TRB8(dst, va, OFF) asm volatile("ds_read_b64_tr_b8 %0, %1 offset:%2" : "=v"(dst) : "v"(va), "n"(OFF) : "memory")
    int e0 = p.eidx[(size_t)t0 * 128 + lane], e1 = p.eidx[(size_t)t0 * 128 + 64 + lane];
    float wA = p.gw[(size_t)t0 * 128 + lane], wB = p.gw[(size_t)t0 * 128 + 64 + lane];
#pragma unroll
    for (int s = 0; s < 16; ++s) ISSUE_V(s, e0, 2 * s);
    asm volatile("s_waitcnt vmcnt(0)" ::: "memory");
#pragma unroll 1
    for (int it = 0; it < ntok; ++it) {
        const int t = t0 + it;
        const int tn = (it + 1 < ntok) ? t + 1 : t;
        const int e0n = p.eidx[(size_t)tn * 128 + lane], e1n = p.eidx[(size_t)tn * 128 + 64 + lane];
        const float wAn = p.gw[(size_t)tn * 128 + lane], wBn = p.gw[(size_t)tn * 128 + 64 + lane];
        float wmax = fmaxf(fabsf(wA), fabsf(wB));
#pragma unroll
        for (int o = 32; o > 0; o >>= 1) wmax = fmaxf(wmax, __shfl_xor(wmax, o));
        const float Sw = fmaxf(wmax * (1.0f / 127.0f), 1e-30f), invS = 1.0f / Sw;
        const int wqa = (int)rintf(wA * invS), wqb = (int)rintf(wB * invS);
        const int wqsum = wave_isum(wqa + wqb);
        int WpA = (wqa & 0xff) << (8 * (lane & 3)), WpB = (wqb & 0xff) << (8 * (lane & 3));
        WpA |= __builtin_amdgcn_update_dpp(0, WpA, 0xB1, 0xf, 0xf, false); WpA |= __builtin_amdgcn_update_dpp(0, WpA, 0x4E, 0xf, 0xf, false);
        WpB |= __builtin_amdgcn_update_dpp(0, WpB, 0xB1, 0xf, 0xf, false); WpB |= __builtin_amdgcn_update_dpp(0, WpB, 0x4E, 0xf, 0xf, false);
        int acci[16];
#pragma unroll
        for (int i = 0; i < 16; ++i) acci[i] = 0;
#define VB_BATCH(b) do { \
            asm volatile("s_waitcnt vmcnt(12)" ::: "memory"); \
            const int wl_ = 8 * ((4 * Bq + (b)) & 7); \
            const int W0_ = __builtin_amdgcn_readlane(wsel_, wl_), W1_ = __builtin_amdgcn_readlane(wsel_, wl_ + 4); \
            u32x2 d_[8]; \
            TRB8(d_[0], trE, (b) * 4096 + 0);   TRB8(d_[1], trO, (b) * 4096 + 64);  TRB8(d_[2], trE, (b) * 4096 + 128); TRB8(d_[3], trO, (b) * 4096 + 192); \
            TRB8(d_[4], trE, (b) * 4096 + 256); TRB8(d_[5], trO, (b) * 4096 + 320); TRB8(d_[6], trE, (b) * 4096 + 384); TRB8(d_[7], trO, (b) * 4096 + 448); \
            asm volatile("s_waitcnt lgkmcnt(0)" : "+v"(d_[0]), "+v"(d_[1]), "+v"(d_[2]), "+v"(d_[3]), "+v"(d_[4]), "+v"(d_[5]), "+v"(d_[6]), "+v"(d_[7])); \
            _Pragma("unroll") for (int s_ = 0; s_ < 4; ++s_) ISSUE_V(4 * (b) + s_, vsel_, vln_ + 2 * (4 * (b) + s_));        \
            _Pragma("unroll") for (int i = 0; i < 8; ++i) { \
                const unsigned lo0 = d_[i].x & 0x0F0F0F0Fu, hi0 = (d_[i].x >> 4) & 0x0F0F0F0Fu, lo1 = d_[i].y & 0x0F0F0F0Fu, hi1 = (d_[i].y >> 4) & 0x0F0F0F0Fu; \
                acci[2 * i] = __builtin_amdgcn_sdot4((int)lo0, W0_, acci[2 * i], false); acci[2 * i] = __builtin_amdgcn_sdot4((int)lo1, W1_, acci[2 * i], false); \
                acci[2 * i + 1] = __builtin_amdgcn_sdot4((int)hi0, W0_, acci[2 * i + 1], false); acci[2 * i + 1] = __builtin_amdgcn_sdot4((int)hi1, W1_, acci[2 * i + 1], false); } \
            __builtin_amdgcn_sched_barrier(0); } while (0)
        asm volatile(".p2align 6\n\ts_nop 0\n\ts_nop 0\n\ts_nop 0\n\ts_nop 0\n\ts_nop 0\n\ts_nop 0\n\ts_nop 0\n\ts_nop 0\n\ts_nop 0\n\ts_nop 0\n\ts_nop 0\n\ts_nop 0");
#pragma unroll 1
        for (int Bq = 0; Bq < 4; ++Bq) {
            int wsel_ = (Bq < 2) ? WpA : WpB; int vsel_ = (Bq == 0) ? e0 : ((Bq == 3) ? e0n : e1); asm volatile("" : "+v"(wsel_), "+v"(vsel_));
            const int vln_ = ((Bq + 1) & 1) * 32;
            VB_BATCH(0); VB_BATCH(1); VB_BATCH(2); VB_BATCH(3);
        }
#undef VB_BATCH
        float* outp = outbase + ((size_t)t & tmask) * D;
        const int c0 = 32 * (lane >> 4) + 2 * (lane & 15);
        typedef float f32x2 __attribute__((ext_vector_type(2)));
        unsigned xw[8];
#pragma unroll
        for (int i = 0; i < 8; ++i) xw[i] = *(const unsigned*)(p.x1 + (size_t)t * D + c0 + 128 * i);
        float y[16]; float s = 0.f;
#pragma unroll
        for (int i = 0; i < 8; ++i) {
            const f32x2 g2 = *(const f32x2*)(lvec + c0 + 128 * i);
            const float f0 = (float)(acci[2 * i] - 8 * wqsum) * Sw, f1 = (float)(acci[2 * i + 1] - 8 * wqsum) * Sw;
            const float v0 = ALPHA * bflo(xw[i]) + g2[0] * f0, v1 = ALPHA * bfhi(xw[i]) + g2[1] * f1;
            y[2 * i] = v0; y[2 * i + 1] = v1; s += v0 + v1;
        }
        const float mu = wave_sum(s) * (1.0f / D);
        float q = 0.f;
#pragma unroll
        for (int i = 0; i < 16; ++i) { y[i] -= mu; q += y[i] * y[i]; }
        const float rsd = rsqrtf(wave_sum(q) * (1.0f / D) + LN_EPS);
#pragma unroll
        for (int i = 0; i < 8; ++i) {
            const f32x2 gg = *(const f32x2*)(lvec + 1024 + c0 + 128 * i), bb = *(const f32x2*)(lvec + 2048 + c0 + 128 * i);
            f32x2 o; o[0] = y[2 * i] * rsd * gg[0] + bb[0]; o[1] = y[2 * i + 1] * rsd * gg[1] + bb[1];
            *(f32x2*)(outp + c0 + 128 * i) = o;
        }
        e0 = e0n; e1 = e1n; wA = wAn; wB = wBn;
    }
#undef ISSUE_V
#undef TRB8
}


#define XB_TMO      128
#define XB_XCNT(j)  (256  + 64 * (j))
#define XB_XSUB(j)  (1280 + 64 * (j))
#define XB_XGEN(j)  (2304 + 64 * (j))
#define XB_TOP      3328
#define XB_TOPGEN   3392
#define XCD_BAR_WORDS 3456
#define XB_SPIN_CAP (1u << 20)
#define LAS __attribute__((address_space(3)))
__device__ __forceinline__ unsigned xb_ld(unsigned* p)              { return __hip_atomic_load(p, __ATOMIC_RELAXED, __HIP_MEMORY_SCOPE_AGENT); }
__device__ __forceinline__ unsigned xb_add(unsigned* p, unsigned v) { return __hip_atomic_fetch_add(p, v, __ATOMIC_RELAXED, __HIP_MEMORY_SCOPE_AGENT); }
__device__ __forceinline__ unsigned xb_xcc_id() { return (unsigned)__builtin_amdgcn_s_getreg((3 << 11) | 20) & 0xFu; }
#define XB_SPIN(cond, bar) do { unsigned _sp = 0; while (cond) { __builtin_amdgcn_s_sleep(1); \
    if ((++_sp & 255u) == 0u) { if (xb_ld(&(bar)[XB_TMO])) break; if (_sp > XB_SPIN_CAP) { atomicAdd(&(bar)[XB_TMO], 1u); break; } } } } while (0)
struct XcdBarrier { unsigned* bar; unsigned x; volatile LAS unsigned* st; };
__device__ __forceinline__ XcdBarrier xcd_barrier_post(unsigned* bar, volatile LAS unsigned* st) {
    XcdBarrier b; b.bar = bar; b.x = xb_xcc_id(); b.st = st;
    if (threadIdx.x == 0) (void)xb_add(&bar[XB_XCNT(b.x)], 1u);
    return b;
}
__device__ __forceinline__ void xcd_barrier_complete(unsigned* bar, unsigned x, unsigned& nloc, unsigned& nx) {
    const unsigned G = gridDim.x * gridDim.y * gridDim.z;
    unsigned sum, cnt, mine, sp = 0u;
    for (;;) {
        sum = 0u; cnt = 0u; mine = 0u;
#pragma unroll
        for (unsigned j = 0; j < 16; ++j) { const unsigned c = xb_ld(&bar[XB_XCNT(j)]); sum += c; cnt += (c > 0u) ? 1u : 0u; mine = (j == x) ? c : mine; }
        if (sum == G) break;
        __builtin_amdgcn_s_sleep(1);
        if ((++sp & 255u) == 0u) { if (xb_ld(&bar[XB_TMO])) break; if (sp > XB_SPIN_CAP) { atomicAdd(&bar[XB_TMO], 1u); break; } }
    }
    nloc = mine > 0u ? mine : 1u; nx = cnt > 0u ? cnt : 1u;
}
__device__ __forceinline__ void xcd_barrier(const XcdBarrier& b) {
    asm volatile("s_waitcnt vmcnt(0)" ::: "memory");
    __syncthreads();
    if (threadIdx.x == 0) {
        unsigned* bar = b.bar;
        __builtin_amdgcn_s_waitcnt(0);
        unsigned nloc = b.st[0], nx = b.st[1];
        if (nloc == 0u) { xcd_barrier_complete(bar, b.x, nloc, nx); b.st[0] = nloc; b.st[1] = nx; }
        const unsigned old = xb_add(&bar[XB_XSUB(b.x)], 1u);
        const unsigned gen = old / nloc;
        if (old + 1u == (gen + 1u) * nloc) {
            __builtin_amdgcn_fence(__ATOMIC_RELEASE, "agent");
            asm volatile("s_waitcnt vmcnt(0)" ::: "memory");
            const unsigned og = xb_add(&bar[XB_TOP], 1u);
            const unsigned tg = og / nx;
            if (og + 1u == (tg + 1u) * nx) xb_add(&bar[XB_TOPGEN], 1u);
            else XB_SPIN(xb_ld(&bar[XB_TOPGEN]) == tg, bar);
            __builtin_amdgcn_fence(__ATOMIC_ACQUIRE, "agent");
            xb_add(&bar[XB_XGEN(b.x)], 1u);
            asm volatile("s_waitcnt vmcnt(0)" ::: "memory");
        } else {
            XB_SPIN(xb_ld(&bar[XB_XGEN(b.x)]) == gen, bar);
            __builtin_amdgcn_fence(__ATOMIC_ACQUIRE, "agent");
            asm volatile("s_waitcnt vmcnt(0)" ::: "memory");
        }
    }
    __syncthreads();
}

constexpr int MEGA_LDS0 = ATT_LDS > GEMM_LDS ? ATT_LDS : GEMM_LDS;
constexpr int MEGA_LDS = MEGA_LDS0 > PEER_LDS ? MEGA_LDS0 : PEER_LDS;
__global__ __launch_bounds__(256, 2) void mega_fwd(Params p) {
    cooperative_groups::grid_group grid = cooperative_groups::this_grid();
    const int nblk = gridDim.x, bid = blockIdx.x;
    volatile LAS unsigned* xst = (volatile LAS unsigned*)(smem + MEGA_LDS);
    if (threadIdx.x == 0) { xst[0] = 0u; xst[1] = 0u; }
    __syncthreads();
    const XcdBarrier xb = xcd_barrier_post(p.bar, xst);
    for (int it = bid; it < PREP_MOD; it += nblk) mod_item(p, it);
    if (__builtin_expect(p.out == nullptr, 0)) grid.sync();
    xcd_barrier(xb);
    if ((bid >> 3) & 1) {
        for (int it = bid; it < PREP_REST; it += nblk) prep_item(p, it);
        for (int mt = bid; mt < T / 128; mt += nblk) modulate_rows(p.x, p.mod, SH1, SC1, p.hbuf, mt * 128, 128);
    } else {
        for (int mt = bid; mt < T / 128; mt += nblk) modulate_rows(p.x, p.mod, SH1, SC1, p.hbuf, mt * 128, 128);
        for (int it = bid; it < PREP_REST; it += nblk) prep_item(p, it);
    }
    xcd_barrier(xb);
    {
        const int x = bid & 7, rank = bid >> 3, per = nblk >> 3;
        EpiProj epi{p.proj};
        for (int mt = rank; mt < T / 128; mt += per) gemm_tile(p.hbuf, p.w_in_t, INW, mt * 128, x * 256, smem, epi);
        for (int mt = bid; mt < T / 128; mt += nblk) gemm_tile(p.hbuf, p.w_in_t, INW, mt * 128, 8 * 256, smem, epi);
    }
    xcd_barrier(xb);
    {
        const float lam = p.scal[0];
        const int xcd = bid & 7, rank = bid >> 3, per = nblk >> 3;
        for (int r0 = 0; r0 < ATT_ITEMS; r0 += nblk) { const int item = r0 + xcd * per + rank; if (item < ATT_ITEMS) attn_item(p, item, lam); }
    }
    xcd_barrier(xb);
    for (int mt = bid; mt < T / 128; mt += nblk) {
        { EpiY1 epi{p.x, p.mod, p.y1};
          for (int nt = 0; nt < D / 256; ++nt) gemm_tile(p.attn, p.w_out_t, D, mt * 128, nt * 256, smem, epi); }
        __syncthreads();
        ln1_rows(p, mt * 128);
        __syncthreads();
        for (int nt = 0; nt < 8; ++nt) { EpiTopk epi{p.hk, 2 * nt}; gemm_tile(p.hbuf, p.weff_t, 2048, mt * 128, nt * 256, smem, epi); }
        __syncthreads();
        route_combine(p, mt * 128);
        __syncthreads();
        const int ptid = opaque_tid(), lane = ptid & 63, wid = wave_of(ptid);
        peer_u(p, mt * 128 + wid * 32, 32, lane);
        __syncthreads();
    }
    xcd_barrier(xb);
    for (int mt = bid; mt < T / 128; mt += nblk) {
        const int ptid = opaque_tid(), lane = ptid & 63, wid = wave_of(ptid);
        {
            float* lv = (float*)smem; const int bb = (mt * 128) / S;
            *(f32x4*)(lv + ptid * 4) = *(const f32x4*)(p.mod + bb * MODW + G2 + ptid * 4);
            *(f32x4*)(lv + 1024 + ptid * 4) = *(const f32x4*)(p.ln2_g + ptid * 4);
            *(f32x4*)(lv + 2048 + ptid * 4) = *(const f32x4*)(p.ln2_b + ptid * 4);
            __syncthreads();
        }
        peer_v(p, mt * 128 + wid * 32, 32, lane, wid, p.out, ~(size_t)0, (const float*)smem);
        __syncthreads();
    }
}
}

extern "C" void kernel_launch(void* const* d_in, const int* in_sizes, int n_in, void* d_out, int out_size, void* d_ws, size_t ws_size, hipStream_t stream) {
    Params p{};
    p.x = (const float*)d_in[0]; p.c = (const float*)d_in[1]; p.w_ada = (const float*)d_in[2]; p.b_ada = (const float*)d_in[3];
    p.w_in = (const float*)d_in[4]; p.lq1 = (const float*)d_in[5]; p.lk1 = (const float*)d_in[6]; p.lq2 = (const float*)d_in[7]; p.lk2 = (const float*)d_in[8];
    p.subln_g = (const float*)d_in[9]; p.sinks = (const float*)d_in[10]; p.w_out = (const float*)d_in[11]; p.ln1_g = (const float*)d_in[12]; p.ln1_b = (const float*)d_in[13];
    p.w_pq = (const float*)d_in[14]; p.sub_keys = (const float*)d_in[15]; p.u_tab = (const float*)d_in[16]; p.v_tab = (const float*)d_in[17];
    p.ln2_g = (const float*)d_in[18]; p.ln2_b = (const float*)d_in[19];
    p.out = (float*)d_out;
    char* ws = (char*)d_ws; const size_t MiB = 1ull << 20;
    p.mod = (float*)(ws);
    p.bar = (unsigned*)(ws + 768 * 1024);
    p.scal = (float*)(ws + 768 * 1024 + 16384);
    p.w_in_t = (bf16_t*)(ws + 1 * MiB);
    p.w_out_t = (bf16_t*)(ws + 6 * MiB);
    p.weff_t = (bf16_t*)(ws + 8 * MiB);
    p.u_q = (unsigned char*)(ws + 12 * MiB);
    p.v_q = (unsigned char*)(ws + 28 * MiB);
    p.u_sc = (float*)(ws + 44 * MiB);
    p.v_sc = (float*)(ws + 44 * MiB + 65536);
    p.v_m = (unsigned char*)(ws + 45 * MiB);
    p.u_m = (unsigned char*)(ws + 46 * MiB);
    p.hbuf = (bf16_t*)(ws + 76 * MiB);
    p.proj = (bf16_t*)(ws + 204 * MiB);
    p.attn = (bf16_t*)(ws + 492 * MiB);
    p.x1 = p.attn;
    p.y1 = (bf16_t*)(ws + 332 * MiB);
    p.hq = (unsigned*)(ws + 620 * MiB);
    p.hsc = (float*)(ws + 684 * MiB);
    p.hk = (int*)(ws + 204 * MiB);
    p.eidx = (int*)(ws + 268 * MiB);
    p.gw = (float*)(ws + 300 * MiB);

    static int grid_blocks = 0;
    if (!grid_blocks) {
        int dev = 0, cus = 0, per_cu = 0;
        (void)hipGetDevice(&dev);
        (void)hipDeviceGetAttribute(&cus, hipDeviceAttributeMultiprocessorCount, dev);
        (void)hipFuncSetAttribute((const void*)mega_fwd, hipFuncAttributeMaxDynamicSharedMemorySize, MEGA_LDS + 16);
        (void)hipOccupancyMaxActiveBlocksPerMultiprocessor(&per_cu, mega_fwd, 256, MEGA_LDS + 16);
        if (per_cu > 2) per_cu = 2;
        grid_blocks = cus * per_cu;
        grid_blocks -= grid_blocks % 8;
    }
    (void)hipMemsetAsync(p.bar, 0, XCD_BAR_WORDS * sizeof(unsigned), stream);
    void* args[] = {&p};
    hipError_t e = hipLaunchCooperativeKernel((const void*)mega_fwd, dim3(grid_blocks), dim3(256), args, MEGA_LDS + 16, stream);
    if (e != hipSuccess) fprintf(stderr, "cooperative launch failed: %s (grid %d)\n", hipGetErrorString(e), grid_blocks);
}
```
